# Optimizing an MI355X kernel written in HIP

```python
import jax
import jax.numpy as jnp
from jax import lax

D_MODEL = 1024
BATCH = 8
SEQ = 4096
DEPTH = 2

GRID_W = 64
CTX_LEN = 256
HEAD_DIM = 64
ATT_HEADS = D_MODEL // 256
ATT_KV_HEADS = ATT_HEADS // 2
WIN_HEADS = D_MODEL // 256
WIN_KV_HEADS = WIN_HEADS // 2
RWKV_HEADS = D_MODEL // 128
WINDOW = 128
Q_BLOCK = 128
ROPE_THETA = 10000.0
DECAY_LORA = 64
ICLR_LORA = 64
GATE_LORA = 128
N_EXPERTS = 16
N_EXPERT_GROUPS = 4
GROUP_SCORE_K = 2
TOP_K = 2
EXPERT_FF = D_MODEL
EXPERT_BLOCK = 128
N_MOD = 6
NORM_EPS = 1e-6
GN_EPS = 64e-5

ATT_Q = ATT_HEADS * HEAD_DIM
ATT_KV = ATT_KV_HEADS * HEAD_DIM
WIN_Q = WIN_HEADS * HEAD_DIM
WIN_KV = WIN_KV_HEADS * HEAD_DIM
RWKV_WIDTH = RWKV_HEADS * HEAD_DIM
MIX_WIDTH = ATT_Q + WIN_Q + RWKV_WIDTH
RWKV_COLS = 3 * RWKV_WIDTH + 2 * DECAY_LORA + 2 * ICLR_LORA + GATE_LORA
IN_COLS = ATT_Q + 2 * ATT_KV + WIN_Q + 2 * WIN_KV + RWKV_COLS

kernel_name = 'hybrid_flow_gqa_swa_rwkv7_moe'


def _split(t, sizes):
    offs, acc = [], 0
    for s in sizes[:-1]:
        acc += s
        offs.append(acc)
    return jnp.split(t, offs, axis=-1)


def _rms_norm(x, g):
    xf = x.astype(jnp.float32)
    y = xf * lax.rsqrt(jnp.mean(xf * xf, axis=-1, keepdims=True) + NORM_EPS)
    return (y * g.astype(jnp.float32)).astype(x.dtype)


def _modulate(x, shift, scale):
    return x * (1 + scale) + shift


def _rope_tables(n_tokens):
    rows = n_tokens // GRID_W
    row = jnp.repeat(jnp.arange(rows, dtype=jnp.float32), GRID_W)
    col = jnp.tile(jnp.arange(GRID_W, dtype=jnp.float32), rows)
    n_freq = HEAD_DIM // 4
    inv = ROPE_THETA ** (-jnp.arange(n_freq, dtype=jnp.float32) / n_freq)
    ang = jnp.concatenate([row[:, None] * inv, col[:, None] * inv], axis=-1)
    return jnp.cos(ang), jnp.sin(ang)


def _apply_rope(x, cos, sin):
    c = cos[None, :, None, :].astype(x.dtype)
    s = sin[None, :, None, :].astype(x.dtype)
    x1, x2 = x[..., 0::2], x[..., 1::2]
    return jnp.stack([x1 * c - x2 * s, x1 * s + x2 * c], axis=-1).reshape(x.shape)


def _heads(t, n):
    return t.reshape(t.shape[:-1] + (n, HEAD_DIM))


def _group(q, n_kv):
    return q.reshape(q.shape[:-2] + (n_kv, q.shape[-2] // n_kv, HEAD_DIM))


def _attend(q, k, v, mask=None, sink=None):
    s = jnp.einsum('bqhgd,bkhd->bhgqk', q, k).astype(jnp.float32) * (HEAD_DIM ** -0.5)
    if mask is not None:
        s = jnp.where(mask, s, -jnp.inf)
    if sink is not None:
        col = jnp.broadcast_to(sink.astype(jnp.float32)[None, :, :, None, None], s.shape[:-1] + (1,))
        s = jnp.concatenate([s, col], axis=-1)
    p = jax.nn.softmax(s, axis=-1)
    if sink is not None:
        p = p[..., :-1]
    return jnp.einsum('bhgqk,bkhd->bqhgd', p.astype(v.dtype), v)


def _global_gqa(q, k, v, qc, kc, vc, q_g, k_g, cos, sin, ctx_out):
    B, S = q.shape[:2]
    q = _group(_apply_rope(_rms_norm(_heads(q, ATT_HEADS), q_g), cos, sin), ATT_KV_HEADS)
    k = _apply_rope(_rms_norm(_heads(k, ATT_KV_HEADS), k_g), cos, sin)
    kc = _rms_norm(_heads(kc, ATT_KV_HEADS), k_g)
    vc = _heads(vc, ATT_KV_HEADS)
    keys = jnp.concatenate([kc, k], axis=1)
    vals = jnp.concatenate([vc, _heads(v, ATT_KV_HEADS)], axis=1)
    nb = S // Q_BLOCK
    qb = jnp.moveaxis(q.reshape((B, nb, Q_BLOCK) + q.shape[2:]), 1, 0)
    o = lax.map(lambda qi: _attend(qi, keys, vals), qb)
    o = jnp.moveaxis(o, 0, 1).reshape(B, S, ATT_Q)
    o_c = None
    if ctx_out:
        qc = _group(_rms_norm(_heads(qc, ATT_HEADS), q_g), ATT_KV_HEADS)
        o_c = _attend(qc, kc, vc).reshape(B, kc.shape[1], ATT_Q)
    return o, o_c


def _window_gqa(q, k, v, qc, kc, vc, sink, cos, sin, ctx_out):
    B, S = q.shape[:2]
    n_ctx = kc.shape[1]
    q = _group(_apply_rope(_heads(q, WIN_HEADS), cos, sin), WIN_KV_HEADS)
    k = _apply_rope(_heads(k, WIN_KV_HEADS), cos, sin)
    v = _heads(v, WIN_KV_HEADS)
    kc, vc = _heads(kc, WIN_KV_HEADS), _heads(vc, WIN_KV_HEADS)
    sink = sink.reshape(WIN_KV_HEADS, WIN_HEADS // WIN_KV_HEADS)
    pad = ((0, 0), (Q_BLOCK, Q_BLOCK), (0, 0), (0, 0))
    kp, vp = jnp.pad(k, pad), jnp.pad(v, pad)
    nb = S // Q_BLOCK
    band = 3 * Q_BLOCK
    qb = jnp.moveaxis(q.reshape((B, nb, Q_BLOCK) + q.shape[2:]), 1, 0)
    ctx_mask = jnp.ones((Q_BLOCK, n_ctx), dtype=bool)

    def block(args):
        qi, n = args
        kb = lax.dynamic_slice_in_dim(kp, n * Q_BLOCK, band, axis=1)
        vb = lax.dynamic_slice_in_dim(vp, n * Q_BLOCK, band, axis=1)
        qpos = n * Q_BLOCK + jnp.arange(Q_BLOCK)
        kpos = (n - 1) * Q_BLOCK + jnp.arange(band)
        near = (jnp.abs(kpos[None, :] - qpos[:, None]) <= WINDOW) & (kpos >= 0)[None, :] & (kpos < S)[None, :]
        mask = jnp.concatenate([near, ctx_mask], axis=-1)
        return _attend(qi, jnp.concatenate([kb, kc], axis=1), jnp.concatenate([vb, vc], axis=1), mask, sink)

    o = lax.map(block, (qb, jnp.arange(nb)))
    o = jnp.moveaxis(o, 0, 1).reshape(B, S, WIN_Q)
    o_c = None
    if ctx_out:
        qc = _group(_heads(qc, WIN_HEADS), WIN_KV_HEADS)
        o_c = _attend(qc, kc, vc, sink=sink).reshape(B, n_ctx, WIN_Q)
    return o, o_c


def _centred_shift(t, w):
    tp = jnp.pad(t, ((0, 0), (1, 1), (0, 0)))
    return tp[:, :-2] * w[0] + tp[:, 1:-1] * w[1] + tp[:, 2:] * w[2]


def _wkv7(s0, decay, k, v, kk, a, r):
    emit = r is not None
    xs = [decay, k, v, kk, a] + ([r] if emit else [])
    xs = [jnp.moveaxis(z, 1, 0) for z in xs]

    def step(S, inp):
        w_t, k_t, v_t, kk_t, a_t = inp[:5]
        sa = jnp.einsum('bhvk,bhk->bhv', S, kk_t)
        S = S * w_t[:, :, None, :] - sa[..., None] * (kk_t * a_t)[:, :, None, :] + v_t[..., None] * k_t[:, :, None, :]
        y = jnp.einsum('bhvk,bhk->bhv', S, inp[5]) if emit else None
        return S, y

    S, ys = lax.scan(step, s0, xs)
    return S, (jnp.moveaxis(ys, 0, 1) if emit else None)


def _bidir_wkv7(s0_f, s0_b, decay, kdir, v, kk, a, r):
    flip = lambda z: z[:, ::-1]
    s_f, o_f = _wkv7(s0_f, decay[:, :, 0], kdir[:, :, 0], v, kk, a[:, :, 0], r)
    s_b, o_b = _wkv7(s0_b, flip(decay[:, :, 1]), flip(kdir[:, :, 1]), flip(v), flip(kk), flip(a[:, :, 1]),
                     None if r is None else flip(r))
    out = None if r is None else o_f + flip(o_b)
    return s_f, s_b, out


def _rwkv7(u, uc, conv_w, w0, w2, a0, a2, g2, k_k, k_a, r_k, ln_w, ln_b, ctx_out):
    out_dtype = u.dtype
    f32 = jnp.float32
    conv_w, w0, w2, a0, a2, g2 = (p.astype(f32) for p in (conv_w, w0, w2, a0, a2, g2))
    k_k, k_a, r_k, ln_w, ln_b = (p.astype(f32) for p in (k_k, k_a, r_k, ln_w, ln_b))
    sizes = (RWKV_WIDTH, RWKV_WIDTH, RWKV_WIDTH, 2 * DECAY_LORA, 2 * ICLR_LORA, GATE_LORA)
    hd = lambda z: _heads(z, RWKV_HEADS)

    def prep(t):
        t = _centred_shift(t.astype(f32), conv_w)
        r, k, v, wd, ad, gd = _split(t, sizes)
        lead = t.shape[:2]
        wd = wd.reshape(lead + (2, DECAY_LORA))
        ad = ad.reshape(lead + (2, ICLR_LORA))
        logw = -jax.nn.softplus(-(w0 + jnp.einsum('btjr,jrc->btjc', jnp.tanh(wd), w2))) - 0.5
        decay = jnp.exp(-jnp.exp(logw))
        a = jax.nn.sigmoid(a0 + jnp.einsum('btjr,jrc->btjc', ad, a2))
        kdir = k[:, :, None, :] * (1.0 + (a - 1.0) * k_a)
        kk = hd(k * k_k)
        kk = kk / jnp.maximum(jnp.linalg.norm(kk, axis=-1, keepdims=True), 1e-12)
        return hd(r), hd(v), kk, hd(decay), hd(a), hd(kdir), gd

    def output(o, r, v, kdir, gd):
        mu = jnp.mean(o, axis=-1, keepdims=True)
        var = jnp.mean(jnp.square(o - mu), axis=-1, keepdims=True)
        lead = o.shape[:2]
        on = ((o - mu) * lax.rsqrt(var + GN_EPS)).reshape(lead + (RWKV_WIDTH,)) * ln_w + ln_b
        bonus = jnp.sum(r[:, :, None] * kdir * r_k, axis=-1, keepdims=True).sum(axis=2) * v
        gate = jax.nn.sigmoid(gd) @ g2
        return ((on + bonus.reshape(lead + (RWKV_WIDTH,))) * gate).astype(out_dtype)

    zero = jnp.zeros((u.shape[0], RWKV_HEADS, HEAD_DIM, HEAD_DIM), f32)
    rc, vc, kkc, dc, ac, kdc, gdc = prep(uc)
    s_f, s_b, oc = _bidir_wkv7(zero, zero, dc, kdc, vc, kkc, ac, rc if ctx_out else None)
    o_ctx = output(oc, rc, vc, kdc, gdc) if ctx_out else None
    r, v, kk, dec, a, kdir, gd = prep(u)
    _, _, ol = _bidir_wkv7(s_f, s_b, dec, kdir, v, kk, a, r)
    return output(ol, r, v, kdir, gd), o_ctx


def _moe(xf, w_router, router_bias, wg, wu, wd):
    n_tok, d = xf.shape
    per_group = N_EXPERTS // N_EXPERT_GROUPS
    scores = jax.nn.sigmoid(jnp.dot(xf.astype(jnp.float32), w_router.astype(jnp.float32)))
    biased = (scores + router_bias.astype(jnp.float32)).reshape(n_tok, N_EXPERT_GROUPS, per_group)
    group_score = lax.top_k(biased, GROUP_SCORE_K)[0].sum(axis=-1)
    g_sel = jnp.argmax(group_score, axis=-1).astype(jnp.int32)
    in_group = jnp.take_along_axis(biased, g_sel[:, None, None], axis=1)[:, 0]
    local = lax.top_k(in_group, TOP_K)[1].astype(jnp.int32)
    expert = g_sel[:, None] * per_group + local
    gate = jnp.take_along_axis(scores, expert, axis=1)
    gate = gate / jnp.sum(gate, axis=-1, keepdims=True)
    n_asg = n_tok * TOP_K
    e_flat = expert.reshape(-1)
    tok_flat = jnp.repeat(jnp.arange(n_tok, dtype=jnp.int32), TOP_K)
    order = jnp.argsort(e_flat)
    e_sorted = e_flat[order]
    counts = jnp.zeros((N_EXPERTS,), jnp.int32).at[e_flat].add(1)
    padded = (counts + EXPERT_BLOCK - 1) // EXPERT_BLOCK * EXPERT_BLOCK
    start = jnp.cumsum(counts) - counts
    pend = jnp.cumsum(padded)
    pstart = pend - padded
    slot_sorted = pstart[e_sorted] + jnp.arange(n_asg, dtype=jnp.int32) - start[e_sorted]
    n_slots = -(-n_asg // EXPERT_BLOCK) * EXPERT_BLOCK + N_EXPERTS * EXPERT_BLOCK
    n_blocks = n_slots // EXPERT_BLOCK
    slot_tok = jnp.full((n_slots,), n_tok, jnp.int32).at[slot_sorted].set(tok_flat[order])
    blk_expert = jnp.minimum(
        jnp.searchsorted(pend, jnp.arange(n_blocks, dtype=jnp.int32) * EXPERT_BLOCK, side='right'),
        N_EXPERTS - 1).astype(jnp.int32)
    x_pad = jnp.concatenate([xf, jnp.zeros((1, d), xf.dtype)], axis=0)
    xb = x_pad[slot_tok].reshape(n_blocks, EXPERT_BLOCK, d)

    def expert_ffn(args):
        xi, e = args
        return (jax.nn.silu(xi @ wg[e]) * (xi @ wu[e])) @ wd[e]

    yb = lax.map(expert_ffn, (xb, blk_expert)).reshape(n_slots, d)
    slot = jnp.zeros((n_asg,), jnp.int32).at[order].set(slot_sorted).reshape(n_tok, TOP_K)
    return jnp.einsum('tkd,tk->td', yb[slot], gate.astype(xf.dtype))


def setup_inputs(seed: int = 0) -> dict:
    key = jax.random.key(seed)
    keys = iter(jax.random.split(key, 32))

    def normal(shape, scale):
        return jax.random.normal(next(keys), shape, jnp.float32) * scale

    L, D, C, E, F = DEPTH, D_MODEL, RWKV_WIDTH, N_EXPERTS, EXPERT_FF
    shift_taps = jnp.array([0.2, 0.6, 0.2], jnp.float32)[None, :, None]
    return {
        'x': normal((BATCH, SEQ, D), 1.0),
        'c': normal((BATCH, D), 1.0),
        'ctx': normal((BATCH, CTX_LEN, D), 1.0),
        'c_ctx': normal((D,), 1.0),
        'w_mod': normal((L, D, N_MOD * D), 0.5 * D ** -0.5),
        'b_mod': normal((L, N_MOD * D), 0.02),
        'norm_mix_g': 1.0 + normal((L, D), 0.02),
        'norm_ffn_g': 1.0 + normal((L, D), 0.02),
        'w_in': normal((L, D, IN_COLS), D ** -0.5),
        'q_norm_g': 1.0 + normal((L, HEAD_DIM), 0.02),
        'k_norm_g': 1.0 + normal((L, HEAD_DIM), 0.02),
        'sink_logit': normal((L, WIN_HEADS), 0.5),
        'rwkv_conv': shift_taps + normal((L, 3, RWKV_COLS), 0.05),
        'rwkv_w0': jax.random.uniform(next(keys), (L, 2, C), jnp.float32, -4.0, 1.0),
        'rwkv_w2': normal((L, 2, DECAY_LORA, C), 0.1),
        'rwkv_a0': normal((L, 2, C), 0.5),
        'rwkv_a2': normal((L, 2, ICLR_LORA, C), 0.1),
        'rwkv_g2': normal((L, GATE_LORA, C), GATE_LORA ** -0.5),
        'rwkv_k_k': 0.85 + normal((L, C), 0.05),
        'rwkv_k_a': 1.0 + normal((L, C), 0.05),
        'rwkv_r_k': normal((L, 2, RWKV_HEADS, HEAD_DIM), 0.1),
        'rwkv_ln_w': 1.0 + normal((L, C), 0.02),
        'rwkv_ln_b': normal((L, C), 0.02),
        'w_out': normal((L, MIX_WIDTH, D), MIX_WIDTH ** -0.5),
        'w_router': normal((D, E), D ** -0.5),
        'router_bias': normal((E,), 0.01),
        'e_gate': normal((L, E, D, F), D ** -0.5),
        'e_up': normal((L, E, D, F), D ** -0.5),
        'e_down': normal((L, E, F, D), F ** -0.5),
        'final_norm_g': 1.0 + normal((D,), 0.02),
    }


def reference(x, c, ctx, c_ctx, w_mod, b_mod, norm_mix_g, norm_ffn_g, w_in, q_norm_g, k_norm_g,
              sink_logit, rwkv_conv, rwkv_w0, rwkv_w2, rwkv_a0, rwkv_a2, rwkv_g2, rwkv_k_k, rwkv_k_a,
              rwkv_r_k, rwkv_ln_w, rwkv_ln_b, w_out, w_router, router_bias, e_gate, e_up, e_down,
              final_norm_g):
    B, S, D = x.shape
    n_ctx = ctx.shape[1]
    cos, sin = _rope_tables(S)
    in_sizes = (ATT_Q, ATT_KV, ATT_KV, WIN_Q, WIN_KV, WIN_KV, RWKV_COLS)
    silu_c = jax.nn.silu(c)
    silu_cc = jax.nn.silu(c_ctx)
    h, hc = x, ctx
    for l in range(DEPTH):
        ctx_out = l < DEPTH - 1
        m = jnp.split((silu_c @ w_mod[l] + b_mod[l])[:, None, :], N_MOD, axis=-1)
        mc = jnp.split(silu_cc @ w_mod[l] + b_mod[l], N_MOD, axis=-1)
        u = _split(_modulate(_rms_norm(h, norm_mix_g[l]), m[0], m[1]) @ w_in[l], in_sizes)
        uc = _split(_modulate(_rms_norm(hc, norm_mix_g[l]), mc[0], mc[1]) @ w_in[l], in_sizes)
        oa, oa_c = _global_gqa(u[0], u[1], u[2], uc[0], uc[1], uc[2], q_norm_g[l], k_norm_g[l],
                               cos, sin, ctx_out)
        ob, ob_c = _window_gqa(u[3], u[4], u[5], uc[3], uc[4], uc[5], sink_logit[l], cos, sin, ctx_out)
        oc, oc_c = _rwkv7(u[6], uc[6], rwkv_conv[l], rwkv_w0[l], rwkv_w2[l], rwkv_a0[l], rwkv_a2[l],
                          rwkv_g2[l], rwkv_k_k[l], rwkv_k_a[l], rwkv_r_k[l], rwkv_ln_w[l], rwkv_ln_b[l],
                          ctx_out)
        h = h + m[2] * (jnp.concatenate([oa, ob, oc], axis=-1) @ w_out[l])
        f = _modulate(_rms_norm(h, norm_ffn_g[l]), m[3], m[4]).reshape(B * S, D)
        if ctx_out:
            hc = hc + mc[2] * (jnp.concatenate([oa_c, ob_c, oc_c], axis=-1) @ w_out[l])
            fc = _modulate(_rms_norm(hc, norm_ffn_g[l]), mc[3], mc[4]).reshape(B * n_ctx, D)
            y = _moe(jnp.concatenate([f, fc], axis=0), w_router, router_bias, e_gate[l], e_up[l], e_down[l])
            h = h + m[5] * y[:B * S].reshape(B, S, D)
            hc = hc + mc[5] * y[B * S:].reshape(B, n_ctx, D)
        else:
            y = _moe(f, w_router, router_bias, e_gate[l], e_up[l], e_down[l])
            h = h + m[5] * y.reshape(B, S, D)
    return _rms_norm(h, final_norm_g)
```

```cpp
#include <hip/hip_runtime.h>
#include <cstdio>
#include <cstdint>

#ifndef MK_PER_PHASE
#define MK_PER_PHASE 0
#endif

namespace pg8 {
#define PG8_LAS __attribute__((address_space(3)))
typedef unsigned short bf16_t;
typedef short bf16x8 __attribute__((ext_vector_type(8)));
typedef float f32x4 __attribute__((ext_vector_type(4)));
typedef unsigned u32x4 __attribute__((ext_vector_type(4)));
constexpr int BM = 256, BK = 64, HALF = 128, HTB = HALF * BK * 2, STAGE_BYTES = 8 * HTB, NXCD = 8, WGM = 8;

__host__ __device__ __forceinline__ int lds_byte(int r, int c) { const int st = (r >> 4) * 2 + (c >> 5), rr = r & 15, cc = c & 31, ob = rr * 64 + cc * 2; return st * 1024 + (ob ^ (((ob >> 9) & 1) << 5)); }
__host__ __device__ __forceinline__ void stage_rc(int b, int& R, int& C) { const int st = b / 1024, sb = b % 1024, swz = sb ^ (((sb >> 9) & 1) << 5); R = (st >> 1) * 16 + swz / 64; C = (st & 1) * 32 + (swz % 64) / 2; }
__host__ __device__ __forceinline__ int perm32(int rho) { const int n = rho >> 4, i = rho & 15; return 8 * (i >> 2) + 4 * n + (i & 3); }

struct Unit { int pm, pn; };
struct Gemm { const bf16_t* A; const bf16_t* Bt; int M, N, K; const PG8_LAS int* rmc; };

struct StaticOrder {
    int nM, nN, nwg, G, c;
    __host__ __device__ __forceinline__ void init(int M, int N, int G_, int c_) { nM = M / BM; nN = N / BM; nwg = nM * nN; G = G_; c = c_; }
    __host__ __device__ __forceinline__ bool next(int i, Unit& u) const {
        const long L = (long)i * G + c; if (L >= nwg) return false;
        int wgid = (int)L; { const int q = nwg / NXCD, r = nwg % NXCD, xcd = wgid % NXCD, off = wgid / NXCD; wgid = (xcd < r ? xcd * (q + 1) : r * (q + 1) + (xcd - r) * q) + off; }
        const int nig = WGM * nN, gid = wgid / nig, fm = gid * WGM, gsz = (nM - fm) < WGM ? (nM - fm) : WGM;
        u.pm = fm + ((wgid % nig) % gsz); u.pn = (wgid % nig) / gsz; return true;
    }
};
struct MoeOrder {
    int nM, nN, nwg, G, c; const PG8_LAS int* tb;
    __device__ __forceinline__ void init(int nM_, int nN_, int G_, int c_, const PG8_LAS int* tb_) { nM = nM_; nN = nN_; nwg = nM * nN; G = G_; c = c_; tb = tb_; }
    __device__ __forceinline__ bool next(int i, Unit& u) const {
        const long L = (long)i * G + c; if (L >= nwg) return false;
        int wgid = (int)L; { const int q = nwg / NXCD, r = nwg % NXCD, xcd = wgid % NXCD, off = wgid / NXCD; wgid = (xcd < r ? xcd * (q + 1) : r * (q + 1) + (xcd - r) * q) + off; }
        const int nig = WGM * nN, gid = wgid / nig, fm = gid * WGM, gsz = (nM - fm) < WGM ? (nM - fm) : WGM;
        const int pm = fm + ((wgid % nig) % gsz), pnl = (wgid % nig) / gsz;
        int e = 0;
#pragma unroll
        for (int j = 1; j < 16; ++j) e += (pm >= tb[j]) ? 1 : 0;
        u.pm = pm; u.pn = __builtin_amdgcn_readfirstlane(e * nN + pnl); return true;
    }
};

__device__ __forceinline__ void glds16s(const void* sbase, unsigned voff, unsigned lds_dst) {
    unsigned keep;
    asm volatile("s_mov_b32 %0, m0\n\ts_mov_b32 m0, %3\n\ts_nop 0\n\tglobal_load_lds_dwordx4 %1, %2\n\ts_mov_b32 m0, %0"
                 : "=&s"(keep) : "v"(voff), "s"(sbase), "s"(lds_dst) : "memory");
}
__device__ __forceinline__ unsigned cvt_pk_bf16(float lo, float hi) { unsigned r; asm volatile("v_cvt_pk_bf16_f32 %0, %1, %2" : "=v"(r) : "v"(lo), "v"(hi)); return r; }

template <class Epi, class Sched, bool ALIGN_EPI, bool GATHER>
__device__ __forceinline__ void gemm_phase(PG8_LAS unsigned char* lds, const Gemm g, const Sched& S, const Epi& E, const int tid) {
    const int wid = __builtin_amdgcn_readfirstlane(tid >> 6), lane = tid & 63, wr = wid >> 2, wc = wid & 3, fr = lane & 15, fq = lane >> 4;
    const int K = g.K, nt = K / BK;
    int RA[2], CA[2]; unsigned voffB[2];
#pragma unroll
    for (int i = 0; i < 2; ++i) { int R, C; stage_rc(tid * 16 + i * 8192, R, C); const int Rb = Epi::PERM ? ((R & ~31) + perm32(R & 31)) : R;
        RA[i] = R; CA[i] = C; voffB[i] = (unsigned)(Rb * K + C) * 2u; }
    const size_t kstep = (size_t)(BK * 2);
    const size_t hstep = (size_t)HALF * K * 2;
    const size_t tstep = 2 * hstep;
    const unsigned ldsw = (unsigned)wid * 1024u;
    const unsigned ldsbase = (unsigned)__builtin_amdgcn_readfirstlane((int)((unsigned)(uintptr_t)lds + ldsw));
    const int aoff = lds_byte(wr * 64 + fr, fq * 8), boff = lds_byte(wc * 32 + fr, fq * 8);
#define PG8_SA(b, h) (((b) * 2 + (h)) * HTB)
#define PG8_SB(b, h) ((4 + (b) * 2 + (h)) * HTB)
#define PG8_STAGE(bufoff, gbase, voff) do { _Pragma("unroll") for (int _i = 0; _i < 2; ++_i) \
        glds16s((const char*)(gbase), (voff)[_i], ldsbase + (unsigned)((bufoff) + _i * 8192)); } while (0)
#define PG8_LDA(dst, b, h) do { _Pragma("unroll") for (int m = 0; m < 4; ++m) _Pragma("unroll") for (int k = 0; k < 2; ++k) dst[m][k] = *(const PG8_LAS bf16x8*)(lds + PG8_SA(b, h) + aoff + m * 2048 + k * 1024); } while (0)
#define PG8_LDB(dst, b, h) do { _Pragma("unroll") for (int n = 0; n < 2; ++n) _Pragma("unroll") for (int k = 0; k < 2; ++k) dst[n][k] = *(const PG8_LAS bf16x8*)(lds + PG8_SB(b, h) + boff + n * 2048 + k * 1024); } while (0)
#define PG8_MMA(ai, bj, At, Bt) do { __builtin_amdgcn_s_setprio(1); _Pragma("unroll") for (int m = 0; m < 4; ++m) _Pragma("unroll") for (int n = 0; n < 2; ++n) _Pragma("unroll") for (int k = 0; k < 2; ++k) \
        acc[ai][bj][m][n] = __builtin_amdgcn_mfma_f32_16x16x32_bf16(Bt[n][k], At[m][k], acc[ai][bj][m][n], 0, 0, 0); __builtin_amdgcn_s_setprio(0); } while (0)
#define PG8_WAIT_V(n) asm volatile("s_waitcnt vmcnt(" #n ")" ::: "memory")
#define PG8_WAIT_L(n) asm volatile("s_waitcnt lgkmcnt(" #n ")" ::: "memory")
#define PG8_BAR __builtin_amdgcn_s_barrier()
#define PG8_SCHED __builtin_amdgcn_sched_barrier(0)
#define PG8_AOFF(v, h, ord) do { _Pragma("unroll") for (int _i = 0; _i < 2; ++_i) { \
        if constexpr (GATHER) { const int _idx = g.rmc[(ord) * 256 + (h) * HALF + RA[_i]]; v[_i] = (unsigned)(_idx * K + CA[_i]) * 2u; } \
        else v[_i] = (unsigned)(((h) * HALF + RA[_i]) * K + CA[_i]) * 2u; } } while (0)
    Unit cur, nxt; int ui = 0;
    if (!S.next(0, cur)) return;
    f32x4 acc[2][2][4][2];
#pragma unroll
    for (int a = 0; a < 2; ++a)
#pragma unroll
        for (int b = 0; b < 2; ++b)
#pragma unroll
            for (int m = 0; m < 4; ++m)
#pragma unroll
                for (int n = 0; n < 2; ++n) acc[a][b][m][n] = (f32x4){0.f, 0.f, 0.f, 0.f};
    bf16x8 At[4][2], B0[2][2], B1[2][2];
    unsigned c0[2], c1[2];
    const char* cA = GATHER ? (const char*)g.A : (const char*)g.A + (size_t)cur.pm * tstep; const char* cB = (const char*)g.Bt + (size_t)cur.pn * tstep;
    PG8_AOFF(c0, 0, 0); PG8_AOFF(c1, 1, 0);
    PG8_STAGE(PG8_SB(0, 0), cB, voffB); PG8_STAGE(PG8_SB(0, 1), cB + hstep, voffB); PG8_STAGE(PG8_SA(0, 0), cA, c0); PG8_STAGE(PG8_SA(0, 1), cA, c1);
    if (wr == 1) PG8_BAR;
    PG8_WAIT_V(2); PG8_BAR;
    PG8_STAGE(PG8_SB(1, 0), cB + kstep, voffB); PG8_STAGE(PG8_SA(1, 0), cA + kstep, c0); PG8_STAGE(PG8_SB(1, 1), cB + hstep + kstep, voffB);
    PG8_WAIT_V(6); PG8_BAR;
    for (;;) {
        const bool has_next = S.next(ui + 1, nxt);
        const char* nA = GATHER ? (const char*)g.A : (has_next ? (const char*)g.A + (size_t)nxt.pm * tstep : cA);
        const char* nB = has_next ? (const char*)g.Bt + (size_t)nxt.pn * tstep : cB;
        const int nord = has_next ? ui + 1 : ui;
        for (int t = 0; t < nt; t += 2) {
            const bool last = (t == nt - 2);
            const char* a1 = cA + (size_t)(t + 1) * kstep;
            const char* a2 = last ? nA : cA + (size_t)(t + 2) * kstep; const char* b2 = last ? nB : cB + (size_t)(t + 2) * kstep;
            const char* a3 = a2 + kstep; const char* b3 = b2 + kstep;
            PG8_LDB(B0, 0, 0); PG8_LDB(B1, 0, 1); PG8_SCHED; PG8_LDA(At, 0, 0); PG8_STAGE(PG8_SA(1, 1), a1, c1);
            if constexpr (GATHER) { if (last) { PG8_AOFF(c0, 0, nord); PG8_AOFF(c1, 1, nord); } }
            PG8_WAIT_V(8); PG8_WAIT_L(0); PG8_BAR; PG8_MMA(0, 0, At, B0); PG8_MMA(0, 1, At, B1); PG8_BAR; PG8_SCHED;
            PG8_LDA(At, 0, 1); PG8_STAGE(PG8_SB(0, 0), b2, voffB); PG8_STAGE(PG8_SB(0, 1), b2 + hstep, voffB); PG8_STAGE(PG8_SA(0, 0), a2, c0);
            PG8_WAIT_V(8); PG8_WAIT_L(0); PG8_BAR; PG8_MMA(1, 0, At, B0); PG8_MMA(1, 1, At, B1); PG8_BAR; PG8_SCHED;
            PG8_LDB(B0, 1, 0); PG8_LDB(B1, 1, 1); PG8_SCHED; PG8_LDA(At, 1, 0); PG8_STAGE(PG8_SA(0, 1), a2, c1);
            PG8_WAIT_V(8); PG8_WAIT_L(0); PG8_BAR; PG8_MMA(0, 0, At, B0); PG8_MMA(0, 1, At, B1); PG8_BAR; PG8_SCHED;
            PG8_LDA(At, 1, 1); PG8_STAGE(PG8_SB(1, 0), b3, voffB); PG8_STAGE(PG8_SB(1, 1), b3 + hstep, voffB); PG8_STAGE(PG8_SA(1, 0), a3, c0);
            PG8_WAIT_V(8); PG8_WAIT_L(0); PG8_BAR; PG8_MMA(1, 0, At, B0); PG8_MMA(1, 1, At, B1); PG8_BAR; PG8_SCHED;
        }
        if constexpr (ALIGN_EPI) { if (wr == 0) PG8_BAR; }
        E(acc, cur, wr, wc, fr, fq);
        if (!has_next) break;
#pragma unroll
        for (int a = 0; a < 2; ++a)
#pragma unroll
            for (int b = 0; b < 2; ++b)
#pragma unroll
                for (int m = 0; m < 4; ++m)
#pragma unroll
                    for (int n = 0; n < 2; ++n) acc[a][b][m][n] = (f32x4){0.f, 0.f, 0.f, 0.f};
        cur = nxt; cA = nA; cB = nB; ++ui;
        if constexpr (ALIGN_EPI) { if (wr == 1) PG8_BAR; }
    }
    PG8_WAIT_V(0);
    if constexpr (!ALIGN_EPI) { if (wr == 0) PG8_BAR; }
    PG8_BAR;
#undef PG8_SA
#undef PG8_SB
#undef PG8_STAGE
#undef PG8_LDA
#undef PG8_LDB
#undef PG8_MMA
#undef PG8_WAIT_V
#undef PG8_WAIT_L
#undef PG8_BAR
#undef PG8_SCHED
#undef PG8_AOFF
}
}

#include <hip/hip_bf16.h>
#include <cmath>
namespace attn_body {
using bf16=__hip_bfloat16;
using bf16x8=__attribute__((ext_vector_type(8)))short;
using s16x4=__attribute__((ext_vector_type(4)))short;
using f32x16=__attribute__((ext_vector_type(16)))float;
using u32x4=__attribute__((ext_vector_type(4)))unsigned;
constexpr int D=64,DM=1024;
constexpr int NW=8,QBLK=32,QB=QBLK*NW,KVBLK=64;
__device__ __forceinline__ int crow(int r,int hi){return (r&3)+8*(r>>2)+4*hi;}
#define SBAR() __builtin_amdgcn_sched_barrier(0)
__device__ __forceinline__ void wmask(f32x16&p0,f32x16&p1,int d0,int hi){
  const float NEG=-INFINITY; const int kb=d0+4*hi;
  #pragma unroll
  for(int r=0;r<16;++r){const int d=kb+(r&3)+8*(r>>2); if(d>128||d<-128)p0[r]=NEG; if(d+32>128||d+32<-128)p1[r]=NEG;}
}

constexpr int NSLOT=3, SLOTB=8192;
constexpr int LDS_K=0, LDS_V=NSLOT*SLOTB, LDS_WS=2*NSLOT*SLOTB, LDS_OST=LDS_WS+NW*64*4, LDS_BYTES=LDS_OST+NW*4096;
constexpr float C2=0.125f*1.4426950408889634f;
__device__ __forceinline__ void glds16(const void*gsrc,unsigned lds_dst){unsigned keep;
  asm volatile("s_mov_b32 %0, m0\n\ts_mov_b32 m0, %2\n\ts_nop 0\n\tglobal_load_lds_dwordx4 %1, off\n\ts_mov_b32 m0, %0":"=&s"(keep):"v"(gsrc),"s"(lds_dst):"memory");}
__device__ __forceinline__ float max3f(float a,float b,float c){float r;asm("v_max3_f32 %0, %1, %2, %3":"=v"(r):"v"(a),"v"(b),"v"(c));return r;}
__device__ __forceinline__ float max2f(float a,float b){float r;asm("v_max_f32_e32 %0, %1, %2":"=v"(r):"v"(a),"v"(b));return r;}
__device__ __forceinline__ float fadd_s(float a,float b){float r;asm("v_add_f32_e32 %0, %1, %2":"=v"(r):"v"(a),"v"(b));return r;}
__device__ __forceinline__ float fsub_s(float a,float b){float r;asm("v_sub_f32_e32 %0, %1, %2":"=v"(r):"v"(a),"v"(b));return r;}
typedef float f32x2_t __attribute__((ext_vector_type(2))); typedef __bf16 bf16x2_t __attribute__((ext_vector_type(2)));
__device__ __forceinline__ unsigned cvtpk_s(float lo,float hi){f32x2_t v={lo,hi};bf16x2_t b=__builtin_convertvector(v,bf16x2_t);return __builtin_bit_cast(unsigned,b);}
#define WAIT_BAR(N) asm volatile("s_waitcnt vmcnt(" #N ") lgkmcnt(0)\n\ts_barrier":::"memory")

__device__ __forceinline__ void qkt(f32x16&p0,f32x16&p1,const char*Kslot,const bf16x8*qr,const f32x16&negm,int r32,int hi){
  const char*kb=Kslot+hi*1024+r32*16;
  #pragma unroll
  for(int d0=0;d0<4;++d0){
    const bf16x8 b0=*reinterpret_cast<const bf16x8*>(kb+d0*2048);
    const bf16x8 b1=*reinterpret_cast<const bf16x8*>(kb+d0*2048+512);
    if(d0==0){p0=__builtin_amdgcn_mfma_f32_32x32x16_bf16(b0,qr[0],negm,0,0,0);p1=__builtin_amdgcn_mfma_f32_32x32x16_bf16(b1,qr[0],negm,0,0,0);}
    else{p0=__builtin_amdgcn_mfma_f32_32x32x16_bf16(b0,qr[d0],p0,0,0,0);p1=__builtin_amdgcn_mfma_f32_32x32x16_bf16(b1,qr[d0],p1,0,0,0);}}
}
typedef __attribute__((address_space(3))) const char* lds_cptr;
typedef short v4i16_t __attribute__((ext_vector_type(4)));
__device__ __forceinline__ void kload8(bf16x8*kf,lds_cptr kp){
  kf[0]=*(const __attribute__((address_space(3))) bf16x8*)(kp);      kf[1]=*(const __attribute__((address_space(3))) bf16x8*)(kp+512);
  kf[2]=*(const __attribute__((address_space(3))) bf16x8*)(kp+2048); kf[3]=*(const __attribute__((address_space(3))) bf16x8*)(kp+2560);
  kf[4]=*(const __attribute__((address_space(3))) bf16x8*)(kp+4096); kf[5]=*(const __attribute__((address_space(3))) bf16x8*)(kp+4608);
  kf[6]=*(const __attribute__((address_space(3))) bf16x8*)(kp+6144); kf[7]=*(const __attribute__((address_space(3))) bf16x8*)(kp+6656);
}
__device__ __forceinline__ void kload2(bf16x8*kf,lds_cptr kp,int j){ kf[2*j]=*(const __attribute__((address_space(3))) bf16x8*)(kp+j*2048); kf[2*j+1]=*(const __attribute__((address_space(3))) bf16x8*)(kp+j*2048+512); }
__device__ __forceinline__ s16x4 vtr(lds_cptr p){ return __builtin_bit_cast(s16x4,__builtin_amdgcn_ds_read_tr16_b64_v4i16((__attribute__((address_space(3))) v4i16_t*)p)); }
__device__ __forceinline__ float rowmax(const f32x16&p0,const f32x16&p1){
  float a=max3f(p0[0],p0[1],p1[0]),b=max3f(p0[2],p0[3],p1[1]);a=max3f(a,p1[2],p1[3]);
  #pragma unroll
  for(int r=4;r<16;r+=4){a=max3f(a,p0[r],p0[r+1]);b=max3f(b,p0[r+2],p0[r+3]);a=max3f(a,p1[r],p1[r+1]);b=max3f(b,p1[r+2],p1[r+3]);}
  const float m=max2f(a,b);
  auto rr=__builtin_amdgcn_permlane32_swap(__float_as_uint(m),__float_as_uint(m),false,false);
  return max2f(__uint_as_float(rr[0]),__uint_as_float(rr[1]));
}
__device__ __forceinline__ void pv(f32x16*o,int vb,bf16x8 pa0,bf16x8 pa1,bf16x8 pa2,bf16x8 pa3){
  #pragma unroll
  for(int d0=0;d0<2;++d0){s16x4 lo[4],hi[4];
    #pragma unroll
    for(int ks=0;ks<4;++ks){
      asm volatile("ds_read_b64_tr_b16 %0,%1 offset:%c2":"=&v"(lo[ks]):"v"(vb),"i"(d0*4096+ks*1024):"memory");
      asm volatile("ds_read_b64_tr_b16 %0,%1 offset:%c2":"=&v"(hi[ks]):"v"(vb),"i"(d0*4096+ks*1024+512):"memory");}
    asm volatile("s_waitcnt lgkmcnt(0)":::"memory");SBAR();
    #define PK(k) (bf16x8){lo[k][0],lo[k][1],lo[k][2],lo[k][3],hi[k][0],hi[k][1],hi[k][2],hi[k][3]}
    o[d0]=__builtin_amdgcn_mfma_f32_32x32x16_bf16(pa0,PK(0),o[d0],0,0,0);
    o[d0]=__builtin_amdgcn_mfma_f32_32x32x16_bf16(pa1,PK(1),o[d0],0,0,0);
    o[d0]=__builtin_amdgcn_mfma_f32_32x32x16_bf16(pa2,PK(2),o[d0],0,0,0);
    o[d0]=__builtin_amdgcn_mfma_f32_32x32x16_bf16(pa3,PK(3),o[d0],0,0,0);
    #undef PK
  }
}

#ifndef ATTN_STORE16
#define ATTN_STORE16(p,v) (*(u32x4*)(p)=(v))
#endif
template<int THRL,int WIN> __device__ __forceinline__ void attn_unit(const bf16*Qb,const bf16*Kc,const bf16*Vc,int ctxrow,int latrow,int NT,int dq0,float sink2,char*shm,const int tid){
  const int lane=tid&63,r32=lane&31,hi=lane>>5; const int wid=__builtin_amdgcn_readfirstlane(tid>>6);
  const bf16*Qw=Qb+(long)(wid*QBLK)*DM;
  #define TROW(t) ((t)<4?ctxrow+64*(t):latrow+64*((t)-4))
  const unsigned lds0=(unsigned)(uintptr_t)shm;
  float*wsf=(float*)(shm+LDS_WS)+wid*64;
  const bf16*ksrc=Kc+(long)lane*DM+wid*8;
  const bf16*vsrc=Vc+(long)(16*(wid&3)+(lane>>2))*DM+(wid>>2)*32+(lane&3)*8;
  const unsigned kdst=lds0+LDS_K+wid*1024, vdst=lds0+LDS_V+wid*1024;
  #define DMA_K(t,slot) glds16(ksrc+(long)TROW(t)*DM,(unsigned)__builtin_amdgcn_readfirstlane(kdst+(slot)))
  #define DMA_V(t,slot) glds16(vsrc+(long)TROW(t)*DM,(unsigned)__builtin_amdgcn_readfirstlane(vdst+(slot)))
  const int vb0=(int)(lds0+LDS_V)+((lane>>4)&1)*32+(lane&3)*8+(4*hi+((lane&15)>>2))*64;
  const char*Kbase=shm+LDS_K; bf16x8 kf[8];
  const lds_cptr shm3=(lds_cptr)shm; const lds_cptr kp0=shm3+LDS_K+hi*1024+r32*16; const lds_cptr vp0=shm3+LDS_V+((lane>>4)&1)*32+(lane&3)*8+(4*hi+((lane&15)>>2))*64;
  DMA_K(0,0);DMA_V(0,0);DMA_K(1,SLOTB);
  bf16x8 qr[4];
  #pragma unroll
  for(int d0=0;d0<4;++d0)qr[d0]=*reinterpret_cast<const __attribute__((address_space(1))) bf16x8*>((const __attribute__((address_space(1))) bf16*)Qw+((long)r32*DM+d0*16+hi*8));
  float zf_; asm volatile("v_mov_b32 %0, 0":"=v"(zf_));
  float mhat=zf_,l_reg=zf_;f32x16 o[2],negm;
  #pragma unroll
  for(int r=0;r<16;++r){o[0][r]=zf_;o[1][r]=zf_;negm[r]=zf_;}
  asm volatile("":"+v"(negm));
  const int qrel=wid*QBLK+r32;
  #define CMASK(P0,P1,t) do{ if constexpr(WIN!=0){ if((t)>=4) wmask(P0,P1,dq0+64*((t)-4)-qrel,hi); } }while(0)
  bool resc=false;
  #define START(P0,P1) do{ const float rm=rowmax(P0,P1); resc=false; \
    { const float dl=rm; mhat=fadd_s(mhat,dl); \
      _Pragma("unroll") for(int r=0;r<16;++r){P0[r]=fsub_s(P0[r],dl);P1[r]=fsub_s(P1[r],dl);} \
      _Pragma("unroll") for(int r=0;r<16;++r)negm[r]=-mhat; asm volatile("":"+v"(negm)); } \
    _Pragma("unroll") for(int r=0;r<16;++r)P0[r]=__builtin_amdgcn_exp2f(P0[r]); }while(0)
  #define RESC() do{ if(resc){ asm volatile("s_waitcnt lgkmcnt(0)":::"memory"); \
      _Pragma("unroll") for(int d_=0;d_<2;++d_) _Pragma("unroll") for(int r=0;r<16;++r)o[d_][r]*=wsf[crow(r,hi)]; } }while(0)
  f32x16 pA0,pA1,pB0,pB1;
  int sl_prev=0,sl_cur=0,sl_next=SLOTB;
  #define ROT() do{sl_prev=sl_cur;sl_cur=sl_next;sl_next=(sl_next==(NSLOT-1)*SLOTB)?0:sl_next+SLOTB;}while(0)
  DMA_K(2,2*SLOTB);
  WAIT_BAR(3);
  qkt(pA0,pA1,Kbase,qr,negm,r32,hi);asm volatile("s_nop 15\n\ts_nop 7":"+v"(pA0),"+v"(pA1));CMASK(pA0,pA1,0);
  START(pA0,pA1);
  _Pragma("unroll") for(int r=0;r<16;++r)pA1[r]=__builtin_amdgcn_exp2f(pA1[r]);
  WAIT_BAR(0);
  DMA_K(3,0);DMA_V(1,SLOTB);
  ROT();
  kload8(kf,kp0+sl_cur);
  WAIT_BAR(2);
  s16x4 vlo[8],vhi[8]; u32x4 pw0,pw1,pw2,pw3;
  #define PKW(P,B) cvtpk_s(P[B],P[B+1])
  #define PAF(k) __builtin_bit_cast(bf16x8,pw##k)
  #define VFR(i) (bf16x8){vlo[i][0],vlo[i][1],vlo[i][2],vlo[i][3],vhi[i][0],vhi[i][1],vhi[i][2],vhi[i][3]}
  #define PIN(x) asm volatile("":"+v"(x))
  #define MX3(a,b,c) __builtin_fmaxf(__builtin_fmaxf((a),(b)),(c))
  #define GAPA(MF,A0,A1,A2,A3,W0,W1,PW) do{ MF; sacc+=A0; sacc+=A1; sacc+=A2; sacc+=A3; PIN(sacc); W0; W1; PIN(PW); SBAR(); }while(0)
  #define EX(v) __builtin_amdgcn_exp2f(v)
  #define GAPB(MF,X,B) do{ MF; X[B]=EX(X[B]); X[B+1]=EX(X[B+1]); X[B+2]=EX(X[B+2]); X[B+3]=EX(X[B+3]); PIN(X); SBAR(); }while(0)
  #define VRD(i) do{ vlo[i]=vtr(vp_+(((i)>>2)*4096+((i)&3)*1024)); vhi[i]=vtr(vp_+(((i)>>2)*4096+((i)&3)*1024+512)); }while(0)
  #define KRD(G,j) do{ if(G){ kload2(kf,kp0+sl_next,j); SBAR(); } }while(0)
  #define STEP(C0,C1,P0,P1,t,GK,GV,GL) do{ SBAR(); \
    const lds_cptr vp_=vp0+sl_prev; \
    VRD(0); SBAR(); float sacc=(P0[0]+P0[1]); \
    GAPA(C0=__builtin_amdgcn_mfma_f32_32x32x16_bf16(kf[0],qr[0],negm,0,0,0), P0[2],P0[3],P0[4],P0[5],     pw0[0]=PKW(P0,0), pw0[1]=PKW(P0,2), pw0); \
    VRD(4); SBAR(); GAPA(C1=__builtin_amdgcn_mfma_f32_32x32x16_bf16(kf[1],qr[0],negm,0,0,0), P0[6],P0[7],P0[8],P0[9],     pw0[2]=PKW(P0,4), pw0[3]=PKW(P0,6), pw0); \
    VRD(1); SBAR(); GAPA(C0=__builtin_amdgcn_mfma_f32_32x32x16_bf16(kf[2],qr[1],C0,0,0,0),   P0[10],P0[11],P0[12],P0[13], pw1[0]=PKW(P0,8), pw1[1]=PKW(P0,10), pw1); \
    VRD(5); SBAR(); GAPA(C1=__builtin_amdgcn_mfma_f32_32x32x16_bf16(kf[3],qr[1],C1,0,0,0),   P0[14],P0[15],P1[0],P1[1],   pw1[2]=PKW(P0,12),pw1[3]=PKW(P0,14), pw1); \
    VRD(2); SBAR(); GAPA(C0=__builtin_amdgcn_mfma_f32_32x32x16_bf16(kf[4],qr[2],C0,0,0,0),   P1[2],P1[3],P1[4],P1[5],     pw2[0]=PKW(P1,0), pw2[1]=PKW(P1,2), pw2); \
    VRD(6); SBAR(); GAPA(C1=__builtin_amdgcn_mfma_f32_32x32x16_bf16(kf[5],qr[2],C1,0,0,0),   P1[6],P1[7],P1[8],P1[9],     pw2[2]=PKW(P1,4), pw2[3]=PKW(P1,6), pw2); \
    VRD(3); SBAR(); GAPA(C0=__builtin_amdgcn_mfma_f32_32x32x16_bf16(kf[6],qr[3],C0,0,0,0),   P1[10],P1[11],P1[12],P1[13], pw3[0]=PKW(P1,8), pw3[1]=PKW(P1,10), pw3); \
    VRD(7); SBAR(); GAPA(C1=__builtin_amdgcn_mfma_f32_32x32x16_bf16(kf[7],qr[3],C1,0,0,0),   P1[14],P1[15],0.f,0.f,       pw3[2]=PKW(P1,12),pw3[3]=PKW(P1,14), pw3); \
    l_reg+=sacc; \
    if(GK){DMA_K((t)+3,sl_cur);} if(GV){DMA_V((t)+1,sl_next);} \
    CMASK(C0,C1,t); \
    { float a=MX3(C0[0],C0[1],C1[0]),b=MX3(C0[2],C0[3],C1[1]); a=MX3(a,C1[2],C1[3]); \
      _Pragma("unroll") for(int r=4;r<16;r+=4){a=MX3(a,C0[r],C0[r+1]);b=MX3(b,C0[r+2],C0[r+3]);a=MX3(a,C1[r],C1[r+1]);b=MX3(b,C1[r+2],C1[r+3]);} \
      float rm=__builtin_fmaxf(a,b); { auto rr=__builtin_amdgcn_permlane32_swap(__float_as_uint(rm),__float_as_uint(rm),false,false); rm=__builtin_fmaxf(__uint_as_float(rr[0]),__uint_as_float(rr[1])); } \
      resc=false; \
      if(__builtin_expect(__any(rm>(float)THRL),0)){ const float dl=__builtin_fmaxf(rm,0.f); mhat+=dl; \
        _Pragma("unroll") for(int r=0;r<16;++r){C0[r]-=dl;C1[r]-=dl;} \
        _Pragma("unroll") for(int r=0;r<16;++r)negm[r]=-mhat; asm volatile("":"+v"(negm)); \
        const float f=__builtin_amdgcn_exp2f(-dl); l_reg*=f; if(hi==0)wsf[r32]=f; resc=true; } } \
    SBAR(); \
    GAPB(o[0]=__builtin_amdgcn_mfma_f32_32x32x16_bf16(PAF(0),VFR(0),o[0],0,0,0), C0,0); \
    GAPB(o[1]=__builtin_amdgcn_mfma_f32_32x32x16_bf16(PAF(0),VFR(4),o[1],0,0,0), C0,4); \
    KRD(GL,0); GAPB(o[0]=__builtin_amdgcn_mfma_f32_32x32x16_bf16(PAF(1),VFR(1),o[0],0,0,0), C0,8); \
    KRD(GL,1); GAPB(o[1]=__builtin_amdgcn_mfma_f32_32x32x16_bf16(PAF(1),VFR(5),o[1],0,0,0), C0,12); \
    KRD(GL,2); GAPB(o[0]=__builtin_amdgcn_mfma_f32_32x32x16_bf16(PAF(2),VFR(2),o[0],0,0,0), C1,0); \
    KRD(GL,3); GAPB(o[1]=__builtin_amdgcn_mfma_f32_32x32x16_bf16(PAF(2),VFR(6),o[1],0,0,0), C1,4); \
    GAPB(o[0]=__builtin_amdgcn_mfma_f32_32x32x16_bf16(PAF(3),VFR(3),o[0],0,0,0), C1,8); \
    GAPB(o[1]=__builtin_amdgcn_mfma_f32_32x32x16_bf16(PAF(3),VFR(7),o[1],0,0,0), C1,12); \
    }while(0)
  int t=1;
  for(;t+5<NT;t+=2){
    STEP(pB0,pB1,pA0,pA1,t,true,true,true);     WAIT_BAR(2); RESC(); ROT();
    STEP(pA0,pA1,pB0,pB1,t+1,true,true,true);   WAIT_BAR(2); RESC(); ROT();
  }
  #define ENDW(tt) do{ if((tt)+3<NT){WAIT_BAR(2);} else if((tt)+2<NT){WAIT_BAR(1);} else {WAIT_BAR(0);} }while(0)
  for(;t+1<NT;t+=2){
    STEP(pB0,pB1,pA0,pA1,t,(t+3<NT),(t+1<NT),(t+1<NT));       ENDW(t);   RESC(); ROT();
    STEP(pA0,pA1,pB0,pB1,t+1,(t+4<NT),(t+2<NT),(t+2<NT));     ENDW(t+1); RESC(); ROT();
  }
  STEP(pB0,pB1,pA0,pA1,NT-1,false,false,false); RESC();
  { float sacc=pB0[0]+pB0[1]; _Pragma("unroll") for(int r=2;r<16;++r)sacc+=pB0[r]; _Pragma("unroll") for(int r=0;r<16;++r)sacc+=pB1[r]; l_reg+=sacc;
    pw0=(u32x4){PKW(pB0,0),PKW(pB0,2),PKW(pB0,4),PKW(pB0,6)};pw1=(u32x4){PKW(pB0,8),PKW(pB0,10),PKW(pB0,12),PKW(pB0,14)};pw2=(u32x4){PKW(pB1,0),PKW(pB1,2),PKW(pB1,4),PKW(pB1,6)};pw3=(u32x4){PKW(pB1,8),PKW(pB1,10),PKW(pB1,12),PKW(pB1,14)};
    SBAR(); pv(o,vb0+sl_cur,PAF(0),PAF(1),PAF(2),PAF(3)); }
  #undef PKW
  #undef PAF
  #undef VFR
  #undef PIN
  #undef MX3
  #undef GAPA
  #undef GAPB
  #undef EX
  #undef VRD
  #undef KRD
  #undef STEP
  #undef ENDW
  {auto rr=__builtin_amdgcn_permlane32_swap(__float_as_uint(l_reg),__float_as_uint(l_reg),false,false);l_reg=__uint_as_float(rr[0])+__uint_as_float(rr[1]);}
  l_reg+=__builtin_amdgcn_exp2f(sink2-mhat);
  if(hi==0)wsf[32+r32]=l_reg;asm volatile("s_waitcnt lgkmcnt(0)":::"memory");
  float rli[16];
  #pragma unroll
  for(int r=0;r<16;++r)rli[r]=__builtin_amdgcn_rcpf(wsf[32+crow(r,hi)]);
  bf16*Ow=const_cast<bf16*>(Qw);
  { bf16*stg=(bf16*)(shm+LDS_OST)+wid*2048;
    #pragma unroll
    for(int r=0;r<16;++r){const int orow=crow(r,hi);
      #pragma unroll
      for(int d0=0;d0<2;++d0)stg[orow*64+d0*32+r32]=__float2bfloat16(o[d0][r]*rli[r]);}
    asm volatile("s_waitcnt lgkmcnt(0)":::"memory");
    #pragma unroll
    for(int i=0;i<4;++i){const int row=i*8+(lane>>3),ch=lane&7; const u32x4 v=*(const u32x4*)(stg+row*64+ch*8); ATTN_STORE16(Ow+(long)row*DM+ch*8,v);} }
  asm volatile("s_waitcnt lgkmcnt(0)\n\ts_barrier":::"memory");
  #undef DMA_K
  #undef DMA_V
  #undef CMASK
  #undef START
  #undef RESC
  #undef ROT
  #undef TROW
}
constexpr int ATTN_LDS_BYTES=LDS_BYTES;
#undef SBAR
#undef WAIT_BAR
}

namespace rs {
typedef short bf16x8 __attribute__((ext_vector_type(8)));
typedef float f32x16 __attribute__((ext_vector_type(16)));
typedef unsigned u32x4 __attribute__((ext_vector_type(4)));
#define RS_LAS __attribute__((address_space(3)))
#define RS_GAS __attribute__((address_space(1)))
constexpr int CH = 32, NCHUNK = 136, TILE_LD = 72, TILE_BYTES = CH * TILE_LD * 2;
__device__ __forceinline__ int crow(int r, int hi) { return (r & 3) + 8 * (r >> 2) + 4 * hi; }
typedef float f32x2_t __attribute__((ext_vector_type(2))); typedef __bf16 bf16x2_t __attribute__((ext_vector_type(2)));
__device__ __forceinline__ unsigned pk(float lo, float hi) { f32x2_t v = {lo, hi}; bf16x2_t b = __builtin_convertvector(v, bf16x2_t); return __builtin_bit_cast(unsigned, b); }
__device__ __forceinline__ bf16x8 packq(const f32x16& a, int q) { u32x4 w; w.x = pk(a[8 * q], a[8 * q + 1]); w.y = pk(a[8 * q + 2], a[8 * q + 3]); w.z = pk(a[8 * q + 4], a[8 * q + 5]); w.w = pk(a[8 * q + 6], a[8 * q + 7]); return __builtin_bit_cast(bf16x8, w); }
__device__ __forceinline__ f32x16 mf(bf16x8 a, bf16x8 b, f32x16 c) { return __builtin_amdgcn_mfma_f32_32x32x16_bf16(a, b, c, 0, 0, 0); }
__device__ __forceinline__ f32x16 zero16(float z) { f32x16 o;
#pragma unroll
    for (int r = 0; r < 16; ++r) o[r] = z; return o; }
__device__ __forceinline__ float bfl(unsigned w) { return __builtin_bit_cast(float, w << 16); }
__device__ __forceinline__ float bfh(unsigned w) { return __builtin_bit_cast(float, w & 0xffff0000u); }
__device__ __forceinline__ f32x16 unpack16(bf16x8 lo, bf16x8 hi) { const u32x4 a = __builtin_bit_cast(u32x4, lo), b = __builtin_bit_cast(u32x4, hi); f32x16 o;
    o[0] = bfl(a.x); o[1] = bfh(a.x); o[2] = bfl(a.y); o[3] = bfh(a.y); o[4] = bfl(a.z); o[5] = bfh(a.z); o[6] = bfl(a.w); o[7] = bfh(a.w);
    o[8] = bfl(b.x); o[9] = bfh(b.x); o[10] = bfl(b.y); o[11] = bfh(b.y); o[12] = bfl(b.z); o[13] = bfh(b.z); o[14] = bfl(b.w); o[15] = bfh(b.w); return o; }
template <class F> __device__ __forceinline__ void cm_frags(F m, bf16x8 (&f)[2][2]) {
#pragma unroll
    for (int q = 0; q < 2; ++q) { u32x4 a, b;
#pragma unroll
        for (int w = 0; w < 4; ++w) { const int t0 = 16 * q + ((2 * w) & 3) + 8 * ((2 * w) >> 2);
            const unsigned p0 = pk(m(t0), m(t0 + 1)), p1 = pk(m(t0 + 4), m(t0 + 5));
            auto rr = __builtin_amdgcn_permlane32_swap(p0, p1, false, false); a[w] = rr[0]; b[w] = rr[1]; }
        f[0][q] = __builtin_bit_cast(bf16x8, a); f[1][q] = __builtin_bit_cast(bf16x8, b); }
}
template <class F> __device__ __forceinline__ void tm_write(F m, RS_LAS unsigned char* tile, int lane) {
    asm volatile("s_waitcnt lgkmcnt(0)" ::: "memory");
#pragma unroll
    for (int t = 0; t < 32; t += 2) { const unsigned p = pk(m(t), m(t + 1));
        *(RS_LAS unsigned short*)(tile + (t * TILE_LD + lane) * 2) = (unsigned short)(p & 0xffffu); *(RS_LAS unsigned short*)(tile + ((t + 1) * TILE_LD + lane) * 2) = (unsigned short)(p >> 16); }
    asm volatile("s_waitcnt lgkmcnt(0)" ::: "memory");
}
__device__ __forceinline__ void tm_read(RS_LAS unsigned char* tile, int lane, bf16x8 (&f)[4]) {
    const int t = lane & 31, kg = lane >> 5;
#pragma unroll
    for (int q = 0; q < 4; ++q) f[q] = *(const RS_LAS bf16x8*)(tile + (t * TILE_LD + 16 * q + 8 * kg) * 2);
    asm volatile("s_waitcnt lgkmcnt(0)" ::: "memory");
}
__device__ __forceinline__ void tm_read_acc(RS_LAS unsigned char* tile, int lane, bf16x8 (&f)[2][2]) {
    const int t = lane & 31, kg = lane >> 5;
    typedef unsigned u32x2 __attribute__((ext_vector_type(2)));
#pragma unroll
    for (int tau = 0; tau < 2; ++tau)
#pragma unroll
        for (int q = 0; q < 2; ++q) { const u32x2 lo = *(const RS_LAS u32x2*)(tile + (t * TILE_LD + 32 * tau + 16 * q + 4 * kg) * 2), hi2 = *(const RS_LAS u32x2*)(tile + (t * TILE_LD + 32 * tau + 16 * q + 4 * kg + 8) * 2);
            u32x4 w; w.x = lo.x; w.y = lo.y; w.z = hi2.x; w.w = hi2.y; f[tau][q] = __builtin_bit_cast(bf16x8, w); }
    asm volatile("s_waitcnt lgkmcnt(0)" ::: "memory");
}
struct ChunkIn { const unsigned short* p; long rstride; const unsigned short* xl; };
struct LoraIn { const RS_LAS unsigned char* w2; const RS_LAS unsigned char* a2; const float* w0; const float* a0; unsigned short* aout; };
__device__ __forceinline__ void load_col(const ChunkIn& ci, int off, int lane, float (&m)[32]) {
    const unsigned l2 = (unsigned)lane * 2u;
#pragma unroll
    for (int t = 0; t < 32; ++t) m[t] = __builtin_bit_cast(float, (unsigned)(*(const RS_GAS unsigned short*)((const RS_GAS char*)(ci.p + ((long)t * ci.rstride + off)) + l2)) << 16);
    asm volatile("" ::: "memory");
}
template <int MODE> struct ChunkLocal {
    bf16x8 KtC[2][2], VC[2][2], BtC[2][2], KkC[2][2];
    bf16x8 RtA[2][2];
    bf16x8 pQ[2], pMbT[2], pEtT[2], pFtT[2];
    float gamma;
};
#define RS_FENCE() do { asm volatile("" ::: "memory"); __builtin_amdgcn_sched_barrier(0); } while (0)
template <int MODE> __device__ __forceinline__ void chunk_local(ChunkLocal<MODE>& o, const ChunkIn& ci, const LoraIn& lo, int dir, float ka, RS_LAS unsigned char* tile, int lane, float zf) {
    const int hi = lane >> 5, l31 = lane & 31;
    float ec[32], a[32];
    {
        bf16x8 xw[4], xa[4];
#pragma unroll
        for (int q = 0; q < 4; ++q) { const RS_GAS unsigned short* xp = (const RS_GAS unsigned short*)ci.xl + ((long)l31 * ci.rstride + dir * 64 + 16 * q + 8 * hi);
            xw[q] = *(const RS_GAS bf16x8*)xp; xa[q] = *(const RS_GAS bf16x8*)(xp + 128); }
        f32x16 aw[2], aa[2];
#pragma unroll
        for (int tau = 0; tau < 2; ++tau) { aw[tau] = zero16(zf); aa[tau] = zero16(zf);
#pragma unroll
            for (int q = 0; q < 4; ++q) { aw[tau] = mf(xw[q], *(const RS_LAS bf16x8*)(lo.w2 + ((32 * tau + l31) * 72 + 16 * q + 8 * hi) * 2), aw[tau]);
                aa[tau] = mf(xa[q], *(const RS_LAS bf16x8*)(lo.a2 + ((32 * tau + l31) * 72 + 16 * q + 8 * hi) * 2), aa[tau]); } }
        const float w0a = ((const RS_GAS float*)lo.w0)[l31], w0b = ((const RS_GAS float*)lo.w0)[32 + l31], a0a = ((const RS_GAS float*)lo.a0)[l31], a0b = ((const RS_GAS float*)lo.a0)[32 + l31];
        float lwc[32];
#pragma unroll
        for (int r = 0; r < 16; ++r) {
            const float l0 = -0.6065306597126334f * __builtin_amdgcn_rcpf(1.f + __expf(-(w0a + aw[0][r]))), l1 = -0.6065306597126334f * __builtin_amdgcn_rcpf(1.f + __expf(-(w0b + aw[1][r])));
            const float v0 = __builtin_amdgcn_rcpf(1.f + __expf(-(a0a + aa[0][r]))), v1 = __builtin_amdgcn_rcpf(1.f + __expf(-(a0b + aa[1][r])));
            auto rl = __builtin_amdgcn_permlane32_swap(__builtin_bit_cast(unsigned, l0), __builtin_bit_cast(unsigned, l1), false, false);
            auto rv = __builtin_amdgcn_permlane32_swap(__builtin_bit_cast(unsigned, v0), __builtin_bit_cast(unsigned, v1), false, false);
            unsigned rl0 = rl[0], rl1 = rl[1], rv0 = rv[0], rv1 = rv[1]; asm volatile("" : "+v"(rl0), "+v"(rl1), "+v"(rv0), "+v"(rv1));
            lwc[crow(r, 0)] = __builtin_bit_cast(float, rl0); lwc[crow(r, 1)] = __builtin_bit_cast(float, rl1);
            a[crow(r, 0)] = __builtin_bit_cast(float, rv0); a[crow(r, 1)] = __builtin_bit_cast(float, rv1); }
        float c = zf;
#pragma unroll
        for (int t = 0; t < 32; ++t) { c += lwc[t]; ec[t] = __expf(c); }
#pragma unroll
        for (int t = 0; t < 32; t += 2) { const unsigned p = pk(a[t], a[t + 1]);
            ((RS_GAS unsigned short*)lo.aout)[(long)t * ci.rstride + lane] = (unsigned short)(p & 0xffffu); ((RS_GAS unsigned short*)lo.aout)[(long)(t + 1) * ci.rstride + lane] = (unsigned short)(p >> 16); }
    }
    o.gamma = ec[31];
    RS_FENCE();
    bf16x8 KtT[4], BtT[4], KkT[4], pL[2], pLT[2];
    f32x16 aQ;
    float x[32];
    load_col(ci, 1536, lane, x);
    { auto kt = [&](int t) { return x[t] * (t == 0 ? 1.f : ec[t == 0 ? 0 : t - 1]); };
      cm_frags(kt, o.KtC); tm_write(kt, tile, lane); tm_read(tile, lane, KtT); }
    RS_FENCE();
    { auto bt = [&](int t) { return x[t] * a[t] * __builtin_amdgcn_rcpf(ec[t]); };
      if (MODE != 1) cm_frags(bt, o.BtC);
      tm_write(bt, tile, lane); tm_read(tile, lane, BtT); }
    RS_FENCE();
    { f32x16 aL = zero16(zf), aLT = zero16(zf);
#pragma unroll
      for (int q = 0; q < 4; ++q) { aL = mf(KtT[q], BtT[q], aL); aLT = mf(BtT[q], KtT[q], aLT); }
#pragma unroll
      for (int r = 0; r < 16; ++r) { const int row = crow(r, hi); aL[r] = (l31 < row) ? aL[r] : 0.f; aLT[r] = (row < l31) ? aLT[r] : 0.f; }
      pL[0] = packq(aL, 0); pL[1] = packq(aL, 1); pLT[0] = packq(aLT, 0); pLT[1] = packq(aLT, 1); }
    RS_FENCE();
    load_col(ci, 512, lane, x);
    { auto kkf = [&](int t) { return x[t] * (1.f + (a[t] - 1.f) * ka) * __builtin_amdgcn_rcpf(ec[t]); };
      if (MODE != 1) cm_frags(kkf, o.KkC);
      tm_write(kkf, tile, lane); tm_read(tile, lane, KkT); }
    RS_FENCE();
    { f32x16 aMbT = zero16(zf);
#pragma unroll
      for (int q = 0; q < 4; ++q) aMbT = mf(KkT[q], KtT[q], aMbT);
#pragma unroll
      for (int r = 0; r < 16; ++r) aMbT[r] = (crow(r, hi) < l31) ? aMbT[r] : 0.f;
      o.pMbT[0] = packq(aMbT, 0); o.pMbT[1] = packq(aMbT, 1); }
    RS_FENCE();
    if (MODE != 0) {
        bf16x8 RtT[4];
        load_col(ci, 0, lane, x);
        { auto rt = [&](int t) { return x[t] * ec[t]; };
          tm_write(rt, tile, lane); tm_read(tile, lane, RtT); }
        { f32x16 aE = zero16(zf), aF = zero16(zf);
#pragma unroll
          for (int q = 0; q < 4; ++q) { aE = mf(BtT[q], RtT[q], aE); aF = mf(KkT[q], RtT[q], aF); }
#pragma unroll
          for (int r = 0; r < 16; ++r) { const bool keep = crow(r, hi) <= l31; aE[r] = keep ? aE[r] : 0.f; aF[r] = keep ? aF[r] : 0.f; }
          o.pEtT[0] = packq(aE, 0); o.pEtT[1] = packq(aE, 1); o.pFtT[0] = packq(aF, 0); o.pFtT[1] = packq(aF, 1); }
        RS_FENCE();
        tm_read_acc(tile, lane, o.RtA);
        RS_FENCE();
    }
    load_col(ci, 1024, lane, x);
    { auto vf = [&](int t) { return x[t]; }; cm_frags(vf, o.VC); }
    RS_FENCE();
    aQ = unpack16(pLT[0], pLT[1]);
#pragma unroll
    for (int r = 0; r < 16; ++r) aQ[r] = ((crow(r, hi) == l31) ? 1.f : 0.f) - aQ[r];
#pragma unroll
    for (int lev = 0; lev < 4; ++lev) {
        f32x16 nP = mf(pLT[0], pL[0], zero16(zf)); nP = mf(pLT[1], pL[1], nP);
        if (lev < 3) { f32x16 nPT = mf(pL[0], pLT[0], zero16(zf)); nPT = mf(pL[1], pLT[1], nPT); pLT[0] = packq(nPT, 0); pLT[1] = packq(nPT, 1); }
        pL[0] = packq(nP, 0); pL[1] = packq(nP, 1);
        const bf16x8 q0 = packq(aQ, 0), q1 = packq(aQ, 1);
        aQ = mf(pL[0], q0, aQ); aQ = mf(pL[1], q1, aQ);
    }
    o.pQ[0] = packq(aQ, 0); o.pQ[1] = packq(aQ, 1);
}
template <int MODE> __device__ __forceinline__ f32x16 chunk_z(const ChunkLocal<MODE>& o, int tv, float zf) {
    f32x16 aW = mf(o.pMbT[0], o.VC[tv][0], zero16(zf)); aW = mf(o.pMbT[1], o.VC[tv][1], aW);
    const bf16x8 w0 = packq(aW, 0), w1 = packq(aW, 1);
    f32x16 aZ = mf(o.pQ[0], w0, zero16(zf)); aZ = mf(o.pQ[1], w1, aZ);
    return aZ;
}
__device__ __forceinline__ void store_frag(unsigned char* base, int idx, int lane, bf16x8 v) { *(RS_GAS u32x4*)(base + (size_t)idx * 1024 + lane * 16) = __builtin_bit_cast(u32x4, v); }
__device__ __forceinline__ bf16x8 load_frag(const unsigned char* base, int idx, int lane) { return __builtin_bit_cast(bf16x8, *(const RS_GAS u32x4*)(base + (size_t)idx * 1024 + lane * 16)); }
__device__ __forceinline__ void passA_chunk(const ChunkIn& ci, const LoraIn& lo, int dir, float ka, RS_LAS unsigned char* tile, RS_LAS float* gam, unsigned char* dump, unsigned char* dump2, int lane, float zf) {
    const int hi = lane >> 5, l31 = lane & 31;
    ChunkLocal<2> o; chunk_local<2>(o, ci, lo, dir, ka, tile, lane, zf);
    asm volatile("s_waitcnt lgkmcnt(0)" ::: "memory"); gam[lane] = o.gamma; asm volatile("s_waitcnt lgkmcnt(0)" ::: "memory");
    bf16x8 pX[2][2], pZ[2][2];
#pragma unroll
    for (int tv = 0; tv < 2; ++tv) {
        f32x16 aX = mf(o.pQ[0], o.KtC[tv][0], zero16(zf)); aX = mf(o.pQ[1], o.KtC[tv][1], aX); pX[tv][0] = packq(aX, 0); pX[tv][1] = packq(aX, 1);
        const f32x16 aZ = chunk_z<2>(o, tv, zf); pZ[tv][0] = packq(aZ, 0); pZ[tv][1] = packq(aZ, 1); }
#pragma unroll
    for (int tj = 0; tj < 2; ++tj) {
        f32x16 t2 = mf(pX[tj][0], o.pEtT[0], zero16(zf)); t2 = mf(pX[tj][1], o.pEtT[1], t2);
        f32x16 a = unpack16(o.RtA[tj][0], o.RtA[tj][1]);
#pragma unroll
        for (int r = 0; r < 16; ++r) a[r] -= t2[r];
        store_frag(dump2, tj * 2 + 0, lane, packq(a, 0)); store_frag(dump2, tj * 2 + 1, lane, packq(a, 1)); }
#pragma unroll
    for (int tv = 0; tv < 2; ++tv) {
        f32x16 a1 = mf(o.pFtT[0], o.VC[tv][0], zero16(zf)); a1 = mf(o.pFtT[1], o.VC[tv][1], a1);
        f32x16 a2 = mf(o.pEtT[0], pZ[tv][0], zero16(zf)); a2 = mf(o.pEtT[1], pZ[tv][1], a2);
#pragma unroll
        for (int r = 0; r < 16; ++r) a1[r] -= a2[r];
        store_frag(dump2, 4 + tv * 2 + 0, lane, packq(a1, 0)); store_frag(dump2, 4 + tv * 2 + 1, lane, packq(a1, 1)); }
#pragma unroll
    for (int t2 = 0; t2 < 2; ++t2)
#pragma unroll
        for (int t1 = 0; t1 < 2; ++t1) { f32x16 a = mf(pX[t2][0], o.BtC[t1][0], zero16(zf)); a = mf(pX[t2][1], o.BtC[t1][1], a);
            const float g = gam[32 * t1 + l31];
#pragma unroll
            for (int r = 0; r < 16; ++r) a[r] = g * (((t2 == t1 && crow(r, hi) == l31) ? 1.f : 0.f) - a[r]);
            store_frag(dump, (t2 * 2 + t1) * 2 + 0, lane, packq(a, 0)); store_frag(dump, (t2 * 2 + t1) * 2 + 1, lane, packq(a, 1)); }
#pragma unroll
    for (int tj = 0; tj < 2; ++tj)
#pragma unroll
        for (int tv = 0; tv < 2; ++tv) { f32x16 a1 = mf(o.KkC[tj][0], o.VC[tv][0], zero16(zf)); a1 = mf(o.KkC[tj][1], o.VC[tv][1], a1);
            f32x16 a2 = mf(o.BtC[tj][0], pZ[tv][0], zero16(zf)); a2 = mf(o.BtC[tj][1], pZ[tv][1], a2);
#pragma unroll
            for (int r = 0; r < 16; ++r) a1[r] = gam[32 * tj + crow(r, hi)] * (a1[r] - a2[r]);
            store_frag(dump, 8 + (tj * 2 + tv) * 2 + 0, lane, packq(a1, 0)); store_frag(dump, 8 + (tj * 2 + tv) * 2 + 1, lane, packq(a1, 1)); }
}
__device__ __forceinline__ void state_step(const unsigned char* dump, int lane, const bf16x8 (&pS)[4][2], f32x16 (&aS)[4]) {
    bf16x8 M[8], G[8];
#pragma unroll
    for (int i = 0; i < 8; ++i) { M[i] = load_frag(dump, i, lane); G[i] = load_frag(dump, 8 + i, lane); }
#pragma unroll
    for (int tj = 0; tj < 2; ++tj)
#pragma unroll
        for (int tv = 0; tv < 2; ++tv) { f32x16 a = unpack16(G[(tj * 2 + tv) * 2], G[(tj * 2 + tv) * 2 + 1]);
#pragma unroll
            for (int tp = 0; tp < 2; ++tp)
#pragma unroll
                for (int q = 0; q < 2; ++q) a = mf(M[(tp * 2 + tj) * 2 + q], pS[tp * 2 + tv][q], a);
            aS[tj * 2 + tv] = a; }
}
#undef RS_FENCE
#undef RS_LAS
#undef RS_GAS
}

constexpr int NWAVES = 8;
constexpr int NB = 8, SEQ = 4096, D = 1024, NCTX = 256, DEPTH = 2;
constexpr int TL = NB * SEQ, TC = NB * NCTX, T = TL + TC;
constexpr int INC = 2944, INP = 3072, RW = 512, RC = 1920, URP = 2112, SCP = 4160;
constexpr int NEXP = 16, MAXSLOT = 73728;
constexpr float C2 = 0.125f * 1.4426950408889634f;
constexpr float LOG2E = 1.4426950408889634f;

constexpr size_t MiB = 1u << 20;
constexpr size_t WS_CTL = 0, CTL_ZERO_BYTES = 1 * MiB;
constexpr size_t WS_MODS = 1 * MiB;
constexpr size_t WS_ROPE = 2 * MiB;
constexpr size_t WS_TOK = 3 * MiB;
constexpr size_t WS_RMAP = 4 * MiB;
constexpr size_t WS_WIN = 5 * MiB;
constexpr size_t WS_WOUT = 17 * MiB;
constexpr size_t WS_XN = 21 * MiB;
constexpr size_t WS_QKV = 89 * MiB;
constexpr size_t WS_UR = 157 * MiB;
constexpr size_t WS_Y = WS_QKV;
constexpr size_t WS_BIG = 298 * MiB;
constexpr size_t WS_WGU = WS_BIG, WS_WDN = WS_BIG + 64 * MiB, WS_HMID = WS_BIG + 96 * MiB;
constexpr size_t WS_HC = 575 * MiB;
constexpr size_t WS_SGD = 583 * MiB;
constexpr size_t WS_LORA = 592 * MiB;
constexpr size_t WS_END = 593 * MiB;
static_assert(WS_UR + (size_t)T * URP * 2 <= WS_BIG && WS_BIG + (size_t)T * SCP * 2 <= WS_HC && WS_QKV + (size_t)MAXSLOT * D * 2 <= WS_BIG && WS_HMID + (size_t)MAXSLOT * D * 2 <= WS_HC, "d_ws map");
constexpr size_t WS_SCD = WS_UR;
constexpr size_t WS_STF = WS_XN;
constexpr int CW_CNT = 64;
constexpr int CW_CUR = 128;
constexpr int CW_BAR = 4096;

constexpr int RING_BYTES = 131072;
constexpr int RMC_OFF = RING_BYTES, RMC_BYTES = 12288;
constexpr int LDSCTL_OFF = RMC_OFF + RMC_BYTES;
constexpr int LDS_BYTES = 147456;

#define GAS __attribute__((address_space(1)))
#define LAS __attribute__((address_space(3)))
typedef unsigned short bf16;
typedef unsigned v4u __attribute__((ext_vector_type(4)));
typedef unsigned v2u __attribute__((ext_vector_type(2)));
typedef float f32x4 __attribute__((ext_vector_type(4)));
#define LDS_WAIT() asm volatile("s_waitcnt lgkmcnt(0)" ::: "memory")
#define VM_WAIT() asm volatile("s_waitcnt vmcnt(0)" ::: "memory")
__device__ __forceinline__ unsigned f2bf(float f) { unsigned u = __builtin_bit_cast(unsigned, f); return (u + 0x7fffu + ((u >> 16) & 1u)) >> 16; }
__device__ __forceinline__ unsigned pk2(float lo, float hi) { return f2bf(lo) | (f2bf(hi) << 16); }
__device__ __forceinline__ float bf2f(unsigned short b) { return __builtin_bit_cast(float, (unsigned)b << 16); }
__device__ __forceinline__ float bflo(unsigned w) { return __builtin_bit_cast(float, w << 16); }
__device__ __forceinline__ float bfhi(unsigned w) { return __builtin_bit_cast(float, w & 0xffff0000u); }
#define DPP_ADD(v, ctrl) ((v) + __builtin_bit_cast(float, __builtin_amdgcn_update_dpp(0, __builtin_bit_cast(int, (v)), (ctrl), 0xf, 0xf, true)))
__device__ __forceinline__ float quad_sum(float v) { v = DPP_ADD(v, 0xB1); v = DPP_ADD(v, 0x4E); return v; }
__device__ __forceinline__ float row_sum(float v) { v = DPP_ADD(v, 0xB1); v = DPP_ADD(v, 0x4E); v = DPP_ADD(v, 0x141); v = DPP_ADD(v, 0x140); return v; }
__device__ __forceinline__ float wave_sum(float v) {
    v = DPP_ADD(v, 0xB1); v = DPP_ADD(v, 0x4E); v = DPP_ADD(v, 0x141); v = DPP_ADD(v, 0x140);
    const int b = __builtin_bit_cast(int, v);
    const float s0 = __builtin_bit_cast(float, __builtin_amdgcn_readlane(b, 0)), s1 = __builtin_bit_cast(float, __builtin_amdgcn_readlane(b, 16)),
                s2 = __builtin_bit_cast(float, __builtin_amdgcn_readlane(b, 32)), s3 = __builtin_bit_cast(float, __builtin_amdgcn_readlane(b, 48));
    return (s0 + s1) + (s2 + s3);
}
__device__ __forceinline__ float half_sum2(float s) { unsigned a = __builtin_bit_cast(unsigned, s), b; asm volatile("v_mov_b32 %0, %1" : "=v"(b) : "v"(a));
    auto rr = __builtin_amdgcn_permlane32_swap(a, b, false, false); unsigned r0 = rr[0], r1 = rr[1]; asm volatile("" : "+v"(r0), "+v"(r1));
    return __builtin_bit_cast(float, r0) + __builtin_bit_cast(float, r1); }
__device__ __forceinline__ int fresh_lane() { int z; asm volatile("s_mov_b32 %0, 0" : "=s"(z)); return (int)__builtin_amdgcn_mbcnt_hi(~0u, __builtin_amdgcn_mbcnt_lo(~0u, (unsigned)z)); }
__device__ __forceinline__ float sigmoidf_(float x) { return 1.f / (1.f + __expf(-x)); }

#define XB_TMO      128
#define XB_XCNT(j)  (256  + 64 * (j))
#define XB_XSUB(j)  (1280 + 64 * (j))
#define XB_XGEN(j)  (2304 + 64 * (j))
#define XB_TOP      3328
#define XB_TOPGEN   3392
#define XCD_BAR_WORDS 3456
#define XB_SPIN_CAP (1u << 18)
__device__ __forceinline__ unsigned xb_ld(unsigned* p)              { return __hip_atomic_load(p, __ATOMIC_RELAXED, __HIP_MEMORY_SCOPE_AGENT); }
__device__ __forceinline__ unsigned xb_add(unsigned* p, unsigned v) { return __hip_atomic_fetch_add(p, v, __ATOMIC_RELAXED, __HIP_MEMORY_SCOPE_AGENT); }
__device__ __forceinline__ unsigned xb_xcc_id() { return (unsigned)__builtin_amdgcn_s_getreg((3 << 11) | 20) & 0xFu; }
#define XB_SPIN(cond, bar) do { unsigned _sp = 0; while (cond) { __builtin_amdgcn_s_sleep(1); \
    if ((++_sp & 255u) == 0u) { if (xb_ld(&(bar)[XB_TMO])) break; if (_sp > XB_SPIN_CAP) { atomicAdd(&(bar)[XB_TMO], 1u); break; } } } } while (0)
struct XcdBarrier { unsigned* bar; unsigned x; volatile LAS unsigned* st; };
__device__ __forceinline__ XcdBarrier xcd_barrier_post(unsigned* bar, volatile LAS unsigned* st, int tid) {
    XcdBarrier b; b.bar = bar; b.x = xb_xcc_id(); b.st = st;
    if (tid == 0) (void)xb_add(&bar[XB_XCNT(b.x)], 1u);
    return b;
}
__device__ __forceinline__ void xcd_barrier_complete(unsigned* bar, unsigned x, unsigned& nloc, unsigned& nx) {
    const unsigned G = gridDim.x * gridDim.y * gridDim.z;
    unsigned sum, cnt, mine, sp = 0u;
    for (;;) {
        sum = 0u; cnt = 0u; mine = 0u;
#pragma unroll
        for (unsigned j = 0; j < 16; ++j) { const unsigned c = xb_ld(&bar[XB_XCNT(j)]); sum += c; cnt += (c > 0u) ? 1u : 0u; mine = (j == x) ? c : mine; }
        if (sum == G) break;
        __builtin_amdgcn_s_sleep(1);
        if ((++sp & 255u) == 0u) { if (xb_ld(&bar[XB_TMO])) break; if (sp > XB_SPIN_CAP) { atomicAdd(&bar[XB_TMO], 1u); break; } }
    }
    nloc = mine > 0u ? mine : 1u; nx = cnt > 0u ? cnt : 1u;
}
__device__ __forceinline__ void xcd_barrier(const XcdBarrier& b, int tid) {
    asm volatile("s_waitcnt vmcnt(0)" ::: "memory");
    __syncthreads();
    if (tid == 0) {
        unsigned* bar = b.bar;
        __builtin_amdgcn_s_waitcnt(0);
        unsigned nloc = b.st[0], nx = b.st[1];
        if (nloc == 0u) { xcd_barrier_complete(bar, b.x, nloc, nx); b.st[0] = nloc; b.st[1] = nx; }
        const unsigned old = xb_add(&bar[XB_XSUB(b.x)], 1u);
        const unsigned gen = old / nloc;
        if (old + 1u == (gen + 1u) * nloc) {
            __builtin_amdgcn_fence(__ATOMIC_RELEASE, "agent");
            asm volatile("s_waitcnt vmcnt(0)" ::: "memory");
            const unsigned og = xb_add(&bar[XB_TOP], 1u);
            const unsigned tg = og / nx;
            if (og + 1u == (tg + 1u) * nx) xb_add(&bar[XB_TOPGEN], 1u);
            else XB_SPIN(xb_ld(&bar[XB_TOPGEN]) == tg, bar);
            __builtin_amdgcn_fence(__ATOMIC_ACQUIRE, "agent");
            xb_add(&bar[XB_XGEN(b.x)], 1u);
            asm volatile("s_waitcnt vmcnt(0)" ::: "memory");
        } else {
            XB_SPIN(xb_ld(&bar[XB_XGEN(b.x)]) == gen, bar);
            __builtin_amdgcn_fence(__ATOMIC_ACQUIRE, "agent");
            asm volatile("s_waitcnt vmcnt(0)" ::: "memory");
        }
    }
    __syncthreads();
}

struct Args { const float* in[30]; float* out; unsigned char* ws; int ph_lo, ph_hi, use_bar, pad; };
#define CAS __attribute__((address_space(4)))
struct InTab {
    __device__ __forceinline__ const float* operator[](int i) const { return (const float*)(const __attribute__((address_space(1))) float*)((const CAS Args*)__builtin_amdgcn_kernarg_segment_ptr())->in[i]; }
};
struct Ctx {
    InTab in; __attribute__((address_space(1))) float* out; __attribute__((address_space(1))) unsigned char* ws;
    LAS unsigned char* lds; int tid, lane, wave, vcu, G;
    __device__ __forceinline__ unsigned char* wsp() const { return (unsigned char*)ws; }
    __device__ __forceinline__ float* outp() const { return (float*)out; }
    __device__ __forceinline__ unsigned* ctl() const { return (unsigned*)(ws + WS_CTL); }
    __device__ __forceinline__ float* mods(int l) const { return (float*)(ws + WS_MODS) + (size_t)l * 9 * 6144; }
    __device__ __forceinline__ float* ropec() const { return (float*)(ws + WS_ROPE); }
    __device__ __forceinline__ float* ropes() const { return (float*)(ws + WS_ROPE) + 4096 * 32; }
    __device__ __forceinline__ int* tok_e() const { return (int*)(ws + WS_TOK); }
    __device__ __forceinline__ float* tok_g() const { return (float*)(ws + WS_TOK) + 2 * T; }
    __device__ __forceinline__ int* tok_slot() const { return (int*)(ws + WS_TOK) + 4 * T; }
    __device__ __forceinline__ int* rowmap() const { return (int*)(ws + WS_RMAP); }
    __device__ __forceinline__ float* gslot() const { return (float*)(ws + WS_RMAP) + MAXSLOT; }
    __device__ __forceinline__ bf16* w_in_t(int l) const { return (bf16*)(ws + WS_WIN) + (size_t)l * INP * D; }
    __device__ __forceinline__ bf16* w_out_t(int l) const { return (bf16*)(ws + WS_WOUT) + (size_t)l * D * D; }
    __device__ __forceinline__ bf16* xn() const { return (bf16*)(ws + WS_XN); }
    __device__ __forceinline__ bf16* sgd() const { return (bf16*)(ws + WS_SGD); }
    __device__ __forceinline__ bf16* w2t(int l, int j) const { return (bf16*)(ws + WS_LORA) + (size_t)(l * 2 + j) * 512 * 64; }
    __device__ __forceinline__ bf16* a2t(int l, int j) const { return (bf16*)(ws + WS_LORA) + 131072 + (size_t)(l * 2 + j) * 512 * 64; }
    __device__ __forceinline__ bf16* g2t(int l) const { return (bf16*)(ws + WS_LORA) + 262144 + (size_t)l * 512 * 128; }
    __device__ __forceinline__ bf16* qkv() const { return (bf16*)(ws + WS_QKV); }
    __device__ __forceinline__ bf16* ur() const { return (bf16*)(ws + WS_UR); }
    __device__ __forceinline__ bf16* ybuf() const { return (bf16*)(ws + WS_Y); }
    __device__ __forceinline__ bf16* sc() const { return (bf16*)(ws + WS_BIG); }
    __device__ __forceinline__ bf16* wgu() const { return (bf16*)(ws + WS_WGU); }
    __device__ __forceinline__ bf16* wdn() const { return (bf16*)(ws + WS_WDN); }
    __device__ __forceinline__ bf16* hmid() const { return (bf16*)(ws + WS_HMID); }
    __device__ __forceinline__ float* hc() const { return (float*)(ws + WS_HC); }
    __device__ __forceinline__ float* hrow(int row) const { return row < TL ? outp() + (size_t)row * D : hc() + (size_t)(row - TL) * D; }
    __device__ __forceinline__ bf16* hb(int row) const { return row < TL ? (bf16*)outp() + (size_t)row * 2048 : (bf16*)hc() + (size_t)(row - TL) * D; }
    __device__ __forceinline__ const float* xrow(int row) const { return row < TL ? in[0] + (size_t)row * D : in[2] + (size_t)(row - TL) * D; }
};
__device__ __forceinline__ int sample_of(int row) { return row < TL ? (row >> 12) : 8; }

typedef pg8::f32x4 pf4;
struct EpiIn {
    static constexpr bool PERM = true;
    bf16* QKV; bf16* UR;
    __device__ __forceinline__ void operator()(const pf4 (&acc)[2][2][4][2], const pg8::Unit& u, int wr, int wc, int fr, int fq) const {
        const int row0 = u.pm * 256 + wr * 64 + fr;
        bf16* base; int ld, colt;
        if (u.pn < 4) { base = QKV; ld = D; colt = u.pn * 256; } else { base = UR; ld = URP; colt = (u.pn - 4) * 256; }
        const int col0 = colt + wc * 32 + 8 * fq;
#pragma unroll
        for (int ai = 0; ai < 2; ++ai)
#pragma unroll
            for (int m = 0; m < 4; ++m) { bf16* rowp = base + (size_t)(row0 + ai * 128 + m * 16) * ld + col0;
#pragma unroll
                for (int bj = 0; bj < 2; ++bj) { const pf4 v0 = acc[ai][bj][m][0], v1 = acc[ai][bj][m][1]; v4u w;
                    w.x = pg8::cvt_pk_bf16(v0[0], v0[1]); w.y = pg8::cvt_pk_bf16(v0[2], v0[3]); w.z = pg8::cvt_pk_bf16(v1[0], v1[1]); w.w = pg8::cvt_pk_bf16(v1[2], v1[3]);
                    *(v4u*)(rowp + bj * 128) = w; } }
    }
};
struct EpiOut {
    static constexpr bool PERM = true;
    bf16* hb_lat; bf16* hb_ctx; const float* gmix;
    __device__ __forceinline__ void operator()(const pf4 (&acc)[2][2][4][2], const pg8::Unit& u, int wr, int wc, int fr, int fq) const {
        const int r0 = u.pm * 256; const bool isc = r0 >= TL; const int s = isc ? 8 : (r0 >> 12);
        bf16* op = isc ? hb_ctx + (size_t)(r0 - TL) * D : hb_lat + (size_t)r0 * 2048; const size_t opitch = isc ? (size_t)D : (size_t)2048;
        const int col0 = u.pn * 256 + wc * 32 + 8 * fq; const float* gp = gmix + (size_t)s * 6144 + col0;
        pf4 gv[2][2];
#pragma unroll
        for (int bj = 0; bj < 2; ++bj)
#pragma unroll
            for (int n = 0; n < 2; ++n) gv[bj][n] = *(const pf4*)(gp + bj * 128 + 4 * n);
        constexpr int EPD = 3;
        v4u q[8][2];
#pragma unroll
        for (int g = 0; g < 8 + EPD; ++g) {
            if (g < 8) { const bf16* irow = op + (size_t)((g >> 2) * 128 + wr * 64 + (g & 3) * 16 + fr) * opitch + col0;
#pragma unroll
                for (int bj = 0; bj < 2; ++bj) q[g][bj] = *(const v4u*)(irow + bj * 128); }
            if (g >= EPD) { const int h = g - EPD; bf16* orow = op + (size_t)((h >> 2) * 128 + wr * 64 + (h & 3) * 16 + fr) * opitch + col0;
#pragma unroll
                for (int bj = 0; bj < 2; ++bj) { const v4u b = q[h][bj]; const pf4 b0 = {bflo(b.x), bfhi(b.x), bflo(b.y), bfhi(b.y)}, b1 = {bflo(b.z), bfhi(b.z), bflo(b.w), bfhi(b.w)};
                    const pf4 v0 = b0 + gv[bj][0] * acc[h >> 2][bj][h & 3][0], v1 = b1 + gv[bj][1] * acc[h >> 2][bj][h & 3][1]; v4u w;
                    w.x = pg8::cvt_pk_bf16(v0[0], v0[1]); w.y = pg8::cvt_pk_bf16(v0[2], v0[3]); w.z = pg8::cvt_pk_bf16(v1[0], v1[1]); w.w = pg8::cvt_pk_bf16(v1[2], v1[3]);
                    *(v4u*)(orow + bj * 128) = w; } }
            asm volatile("" ::: "memory"); }
    }
};
struct EpiGU {
    static constexpr bool PERM = true;
    bf16* H;
    __device__ __forceinline__ void operator()(const pf4 (&acc)[2][2][4][2], const pg8::Unit& u, int wr, int wc, int fr, int fq) const {
        const int row0 = u.pm * 256 + wr * 64 + fr; const int col0 = (u.pn & 7) * 128 + wc * 32 + 8 * fq;
#pragma unroll
        for (int ai = 0; ai < 2; ++ai)
#pragma unroll
            for (int m = 0; m < 4; ++m) { float h[8];
#pragma unroll
                for (int n = 0; n < 2; ++n)
#pragma unroll
                    for (int i = 0; i < 4; ++i) { const float gt = acc[ai][0][m][n][i], up = acc[ai][1][m][n][i]; h[n * 4 + i] = gt * __builtin_amdgcn_rcpf(1.f + __expf(-gt)) * up; }
                v4u w; w.x = pg8::cvt_pk_bf16(h[0], h[1]); w.y = pg8::cvt_pk_bf16(h[2], h[3]); w.z = pg8::cvt_pk_bf16(h[4], h[5]); w.w = pg8::cvt_pk_bf16(h[6], h[7]);
                *(v4u*)(H + (size_t)(row0 + ai * 128 + m * 16) * D + col0) = w; }
    }
};
struct EpiDN {
    static constexpr bool PERM = true;
    bf16* Y; const float* gs;
    __device__ __forceinline__ void operator()(const pf4 (&acc)[2][2][4][2], const pg8::Unit& u, int wr, int wc, int fr, int fq) const {
        const int row0 = u.pm * 256 + wr * 64 + fr; const int col0 = (u.pn & 3) * 256 + wc * 32 + 8 * fq;
        float g8[8];
#pragma unroll
        for (int i = 0; i < 8; ++i) g8[i] = gs[row0 + (i >> 2) * 128 + (i & 3) * 16];
        asm volatile("" : "+v"(g8[0]), "+v"(g8[1]), "+v"(g8[2]), "+v"(g8[3]), "+v"(g8[4]), "+v"(g8[5]), "+v"(g8[6]), "+v"(g8[7]));
#pragma unroll
        for (int ai = 0; ai < 2; ++ai)
#pragma unroll
            for (int m = 0; m < 4; ++m) { const int row = row0 + ai * 128 + m * 16; const float gt = g8[ai * 4 + m]; bf16* rowp = Y + (size_t)row * D + col0;
#pragma unroll
                for (int bj = 0; bj < 2; ++bj) { const pf4 v0 = acc[ai][bj][m][0] * gt, v1 = acc[ai][bj][m][1] * gt; v4u w;
                    w.x = pg8::cvt_pk_bf16(v0[0], v0[1]); w.y = pg8::cvt_pk_bf16(v0[2], v0[3]); w.z = pg8::cvt_pk_bf16(v1[0], v1[1]); w.w = pg8::cvt_pk_bf16(v1[2], v1[3]);
                    *(v4u*)(rowp + bj * 128) = w; } }
    }
};

__device__ __forceinline__ void transpose_item(const float* W, int K, int N, bf16* WT, int k0, int n0, int drow0, LAS float* scr, int lane) {
#pragma unroll
    for (int i0 = 0; i0 < 32; i0 += 16) { float tw[16];
#pragma unroll
        for (int i = 0; i < 16; ++i) { const int kk = 2 * (i0 + i) + (lane >> 5); tw[i] = W[(size_t)(k0 + kk) * N + n0 + (lane & 31)]; }
        asm volatile("" : "+v"(tw[0]), "+v"(tw[1]), "+v"(tw[2]), "+v"(tw[3]), "+v"(tw[4]), "+v"(tw[5]), "+v"(tw[6]), "+v"(tw[7]), "+v"(tw[8]), "+v"(tw[9]), "+v"(tw[10]), "+v"(tw[11]), "+v"(tw[12]), "+v"(tw[13]), "+v"(tw[14]), "+v"(tw[15]));
#pragma unroll
        for (int i = 0; i < 16; ++i) { const int kk = 2 * (i0 + i) + (lane >> 5); scr[kk * 33 + (lane & 31)] = tw[i]; } }
    LDS_WAIT(); asm volatile("" ::: "memory");
    const int c = lane & 7;
#pragma unroll
    for (int j = 0; j < 4; ++j) { const int n = (lane >> 3) + 8 * j; const LAS float* s = scr + (8 * c) * 33 + n;
        v4u o; o.x = pk2(s[0 * 33], s[1 * 33]); o.y = pk2(s[2 * 33], s[3 * 33]); o.z = pk2(s[4 * 33], s[5 * 33]); o.w = pk2(s[6 * 33], s[7 * 33]);
        *(v4u*)(WT + (size_t)(drow0 + n) * K + k0 + 8 * c) = o; }
    LDS_WAIT(); asm volatile("" ::: "memory");
}
__device__ __forceinline__ void transpose_item64(const float* W, int K, int N, bf16* WT, int k0, int n0, int drow0, LAS unsigned* scr, int lane) {
    f32x4 ta[8], tb[8];
#pragma unroll
    for (int i = 0; i < 8; ++i) { const int idx = i * 64 + lane, kp = idx >> 4, n4 = idx & 15;
        ta[i] = *(const f32x4*)(W + (size_t)(k0 + 2 * kp) * N + n0 + 4 * n4); tb[i] = *(const f32x4*)(W + (size_t)(k0 + 2 * kp + 1) * N + n0 + 4 * n4); }
    asm volatile("" : "+v"(ta[0]), "+v"(ta[1]), "+v"(ta[2]), "+v"(ta[3]), "+v"(ta[4]), "+v"(ta[5]), "+v"(ta[6]), "+v"(ta[7]), "+v"(tb[0]), "+v"(tb[1]), "+v"(tb[2]), "+v"(tb[3]), "+v"(tb[4]), "+v"(tb[5]), "+v"(tb[6]), "+v"(tb[7]));
#pragma unroll
    for (int i = 0; i < 8; ++i) { const int idx = i * 64 + lane, kp = idx >> 4, n4 = idx & 15; const f32x4 a = ta[i], b = tb[i];
        scr[(4 * n4 + 0) * 33 + kp] = pk2(a.x, b.x); scr[(4 * n4 + 1) * 33 + kp] = pk2(a.y, b.y); scr[(4 * n4 + 2) * 33 + kp] = pk2(a.z, b.z); scr[(4 * n4 + 3) * 33 + kp] = pk2(a.w, b.w); }
    LDS_WAIT(); asm volatile("" ::: "memory");
    const int c = lane & 7;
#pragma unroll
    for (int j = 0; j < 8; ++j) { const int n = (lane >> 3) + 8 * j; const LAS unsigned* sp = scr + n * 33 + 4 * c;
        v4u o; o.x = sp[0]; o.y = sp[1]; o.z = sp[2]; o.w = sp[3];
        *(v4u*)(WT + (size_t)(drow0 + n) * K + k0 + 8 * c) = o; }
    LDS_WAIT(); asm volatile("" ::: "memory");
}
__device__ __forceinline__ int win_dest_row(int n0) {
    if (n0 < 256) return n0;
    if (n0 < 384) return 512 + (n0 - 256);
    if (n0 < 512) return 640 + (n0 - 384);
    if (n0 < 768) return 256 + (n0 - 512);
    return n0;
}
__device__ __forceinline__ void phase_prologue(const Ctx& C) {
    LAS float* scr = (LAS float*)(C.lds + C.wave * 16384);
    const int gw = C.vcu * NWAVES + C.wave, NGW = C.G * NWAVES;
    constexpr int I_IN = (D / 64) * (INC / 32), I_OUT = (D / 64) * (D / 32), I_L = I_IN + I_OUT;
    for (int it = gw; it < DEPTH * I_L; it += NGW) {
        const int l = it / I_L; int r = it % I_L;
        if (r < I_IN) { const int nblk = INC / 32, kb = r / nblk, nb = r % nblk; transpose_item(C.in[8] + (size_t)l * D * INC, D, INC, C.w_in_t(l), 64 * kb, 32 * nb, win_dest_row(32 * nb), scr, C.lane); }
        else { r -= I_IN; const int nblk = D / 32, kb = r / nblk, nb = r % nblk; transpose_item(C.in[23] + (size_t)l * D * D, D, D, C.w_out_t(l), 64 * kb, 32 * nb, 32 * nb, scr, C.lane); }
    }
    { const int gt = C.vcu * 512 + C.tid, NGT = C.G * 512;
      for (int i = gt; i < DEPTH * 128 * D / 8; i += NGT) { const int l = i / (128 * D / 8), r = i % (128 * D / 8); *(v4u*)(C.w_in_t(l) + (size_t)INC * D + (size_t)r * 8) = (v4u){0u, 0u, 0u, 0u}; }
      for (int i = gt; i < 2 * 2 * 512 * 64; i += NGT) { const int r = i & 63, c = (i >> 6) & 511, lj = i >> 15;
          ((bf16*)(C.wsp() + WS_LORA))[i] = (bf16)f2bf(C.in[14][((size_t)lj * 64 + r) * 512 + c]); ((bf16*)(C.wsp() + WS_LORA))[131072 + i] = (bf16)f2bf(C.in[16][((size_t)lj * 64 + r) * 512 + c]); }
      for (int i = gt; i < 2 * 512 * 128; i += NGT) { const int q = i & 127, c = (i >> 7) & 511, l = i >> 16; ((bf16*)(C.wsp() + WS_LORA))[262144 + i] = (bf16)f2bf(C.in[17][((size_t)l * 128 + q) * 512 + c]); }
      for (int i = gt; i < 4096 * 32; i += NGT) { const int t = i >> 5, p = i & 31; const float pos = (float)(p < 16 ? (t >> 6) : (t & 63)); const float inv = powf(10000.f, -(float)(p & 15) / 16.f);
          const float ang = pos * inv; C.ropec()[i] = cosf(ang); C.ropes()[i] = sinf(ang); }
    }
    __syncthreads();
    for (int it = C.vcu; it < DEPTH * 96; it += C.G) {
        const int l = it / 96, n0 = (it % 96) * 64;
        LAS float* sc = (LAS float*)C.lds;
        LAS float* part = (LAS float*)(C.lds + 40960);
        for (int i = C.tid; i < 9 * 1024; i += 512) { const int s = i >> 10, k = i & 1023; const float v = s < 8 ? C.in[1][s * 1024 + k] : C.in[3][k]; sc[i] = v / (1.f + __expf(-v)); }
        __syncthreads();
        float a[9];
#pragma unroll
        for (int s = 0; s < 9; ++s) a[s] = 0.f;
        const float* wp = C.in[4] + (size_t)l * D * 6144 + n0 + C.lane;
        for (int k0 = C.wave * 128; k0 < C.wave * 128 + 128; k0 += 16) { float w[16];
#pragma unroll
            for (int i = 0; i < 16; ++i) w[i] = wp[(size_t)(k0 + i) * 6144];
            asm volatile("" : "+v"(w[0]), "+v"(w[1]), "+v"(w[2]), "+v"(w[3]), "+v"(w[4]), "+v"(w[5]), "+v"(w[6]), "+v"(w[7]), "+v"(w[8]), "+v"(w[9]), "+v"(w[10]), "+v"(w[11]), "+v"(w[12]), "+v"(w[13]), "+v"(w[14]), "+v"(w[15]));
#pragma unroll
            for (int i = 0; i < 16; ++i)
#pragma unroll
                for (int s = 0; s < 9; ++s) a[s] += sc[s * 1024 + k0 + i] * w[i]; }
#pragma unroll
        for (int s = 0; s < 9; ++s) part[(C.wave * 9 + s) * 64 + C.lane] = a[s];
        __syncthreads();
        for (int i = C.tid; i < 9 * 64; i += 512) { const int s = i >> 6, n = i & 63; float v = C.in[5][l * 6144 + n0 + n];
#pragma unroll
            for (int w = 0; w < 8; ++w) v += part[(w * 9 + s) * 64 + n];
            C.mods(l)[s * 6144 + n0 + n] = v; }
        __syncthreads();
    }
}
__device__ __forceinline__ void phase_wconv(const Ctx& C, int l) {
    LAS unsigned* scr = (LAS unsigned*)(C.lds + C.wave * 16384);
    const int gw = C.vcu * NWAVES + C.wave, NGW = C.G * NWAVES;
    constexpr int I_M = (D / 64) * (D / 64);
    for (int it = gw; it < NEXP * 3 * I_M; it += NGW) {
        const int e = it / (3 * I_M), r3 = it % (3 * I_M), which = r3 / I_M, r = r3 % I_M, kb = r / 16, nb = r % 16, n0 = 64 * nb;
        const size_t eoff = ((size_t)l * NEXP + e) * D * D;
        if (which == 0) transpose_item64(C.in[26] + eoff, D, D, C.wgu() + (size_t)e * 2048 * D, 64 * kb, n0, 256 * (n0 >> 7) + (n0 & 127), scr, C.lane);
        else if (which == 1) transpose_item64(C.in[27] + eoff, D, D, C.wgu() + (size_t)e * 2048 * D, 64 * kb, n0, 256 * (n0 >> 7) + 128 + (n0 & 127), scr, C.lane);
        else transpose_item64(C.in[28] + eoff, D, D, C.wdn() + (size_t)e * D * D, 64 * kb, n0, n0, scr, C.lane);
    }
}

__device__ __forceinline__ void store_row_bf16(bf16* orow, const f32x4 (&v)[4], int lane) {
    v2u* o8 = (v2u*)orow + lane;
#pragma unroll
    for (int j = 0; j < 4; ++j) { v2u w; w.x = pk2(v[j].x, v[j].y); w.y = pk2(v[j].z, v[j].w); o8[64 * j] = w; }
}
__device__ __forceinline__ void add_yrow(f32x4 (&v)[4], const bf16* yrow, const f32x4 (&g)[4], int lane) {
    const v2u* y8 = (const v2u*)yrow + lane;
#pragma unroll
    for (int j = 0; j < 4; ++j) { const v2u w = y8[64 * j]; v[j].x += g[j].x * bflo(w.x); v[j].y += g[j].y * bfhi(w.x); v[j].z += g[j].z * bflo(w.y); v[j].w += g[j].w * bfhi(w.y); }
}
__device__ __forceinline__ void phase_norm1(const Ctx& C, int l) {
    const int gw = C.vcu * NWAVES + C.wave, NGW = C.G * NWAVES;
    const float* g = C.in[6] + l * D;
    for (int row0 = gw; row0 < T; row0 += 2 * NGW) {
        f32x4 v[2][4]; int sl[2][2]; bool ok[2]; int sm[2];
#pragma unroll
        for (int r = 0; r < 2; ++r) { const int row = row0 + r * NGW; ok[r] = row < T; const int rw = ok[r] ? row : row0; sm[r] = sample_of(rw);
            if (l == 0) { const f32x4* xr = (const f32x4*)C.xrow(rw) + C.lane;
#pragma unroll
                for (int j = 0; j < 4; ++j) v[r][j] = xr[64 * j]; }
            else { const v2u* hr = (const v2u*)C.hb(rw) + C.lane;
#pragma unroll
                for (int j = 0; j < 4; ++j) { const v2u w_ = hr[64 * j]; v[r][j] = (f32x4){bflo(w_.x), bfhi(w_.x), bflo(w_.y), bfhi(w_.y)}; }
                sl[r][0] = C.tok_slot()[2 * rw]; sl[r][1] = C.tok_slot()[2 * rw + 1]; } }
        f32x4 gq[4], sq[2][4], hq[2][4];
        { const f32x4* gp = (const f32x4*)g + C.lane;
#pragma unroll
          for (int j = 0; j < 4; ++j) gq[j] = gp[64 * j];
#pragma unroll
          for (int r = 0; r < 2; ++r) { const f32x4* shp = (const f32x4*)(C.mods(l) + (size_t)sm[r] * 6144) + C.lane; const f32x4* scp = (const f32x4*)(C.mods(l) + (size_t)sm[r] * 6144 + 1024) + C.lane;
#pragma unroll
              for (int j = 0; j < 4; ++j) { hq[r][j] = shp[64 * j]; sq[r][j] = scp[64 * j]; } } }
        if (l != 0) {
            v2u y[2][2][4]; f32x4 gf[2][4];
#pragma unroll
            for (int r = 0; r < 2; ++r) { const f32x4* gp = (const f32x4*)(C.mods(l - 1) + (size_t)sm[r] * 6144 + 5 * 1024) + C.lane;
#pragma unroll
                for (int k = 0; k < 2; ++k) { const v2u* y8 = (const v2u*)(C.ybuf() + (size_t)sl[r][k] * D) + C.lane;
#pragma unroll
                    for (int j = 0; j < 4; ++j) y[r][k][j] = y8[64 * j]; }
#pragma unroll
                for (int j = 0; j < 4; ++j) gf[r][j] = gp[64 * j]; }
            asm volatile("" : "+v"(v[0][0]), "+v"(v[0][1]), "+v"(v[0][2]), "+v"(v[0][3]), "+v"(v[1][0]), "+v"(v[1][1]), "+v"(v[1][2]), "+v"(v[1][3]));
            asm volatile("" : "+v"(y[0][0][0]), "+v"(y[0][0][1]), "+v"(y[0][0][2]), "+v"(y[0][0][3]), "+v"(y[0][1][0]), "+v"(y[0][1][1]), "+v"(y[0][1][2]), "+v"(y[0][1][3]), "+v"(y[1][0][0]), "+v"(y[1][0][1]), "+v"(y[1][0][2]), "+v"(y[1][0][3]), "+v"(y[1][1][0]), "+v"(y[1][1][1]), "+v"(y[1][1][2]), "+v"(y[1][1][3]), "+v"(gf[0][0]), "+v"(gf[0][1]), "+v"(gf[0][2]), "+v"(gf[0][3]), "+v"(gf[1][0]), "+v"(gf[1][1]), "+v"(gf[1][2]), "+v"(gf[1][3]));
#pragma unroll
            for (int r = 0; r < 2; ++r) {
#pragma unroll
                for (int k = 0; k < 2; ++k)
#pragma unroll
                    for (int j = 0; j < 4; ++j) { const v2u w = y[r][k][j]; v[r][j].x += gf[r][j].x * bflo(w.x); v[r][j].y += gf[r][j].y * bfhi(w.x); v[r][j].z += gf[r][j].z * bflo(w.y); v[r][j].w += gf[r][j].w * bfhi(w.y); }
                if (ok[r]) store_row_bf16(C.hb(row0 + r * NGW), v[r], C.lane); }
        }
        if (l == 0) { asm volatile("" : "+v"(v[0][0]), "+v"(v[0][1]), "+v"(v[0][2]), "+v"(v[0][3]), "+v"(v[1][0]), "+v"(v[1][1]), "+v"(v[1][2]), "+v"(v[1][3]));
#pragma unroll
            for (int r = 0; r < 2; ++r) if (ok[r]) store_row_bf16(C.hb(row0 + r * NGW), v[r], C.lane); }
#pragma unroll
        for (int r = 0; r < 2; ++r) {
            float ss = 0.f;
#pragma unroll
            for (int j = 0; j < 4; ++j) ss += (v[r][j].x * v[r][j].x + v[r][j].y * v[r][j].y) + (v[r][j].z * v[r][j].z + v[r][j].w * v[r][j].w);
            const float rstd = 1.f / sqrtf(wave_sum(ss) * (1.f / D) + 1e-6f);
            if (r == 0) asm volatile("" : "+v"(gq[0]), "+v"(gq[1]), "+v"(gq[2]), "+v"(gq[3]), "+v"(sq[0][0]), "+v"(sq[0][1]), "+v"(sq[0][2]), "+v"(sq[0][3]), "+v"(sq[1][0]), "+v"(sq[1][1]), "+v"(sq[1][2]), "+v"(sq[1][3]), "+v"(hq[0][0]), "+v"(hq[0][1]), "+v"(hq[0][2]), "+v"(hq[0][3]), "+v"(hq[1][0]), "+v"(hq[1][1]), "+v"(hq[1][2]), "+v"(hq[1][3]));
#pragma unroll
            for (int j = 0; j < 4; ++j) v[r][j] = (v[r][j] * rstd * gq[j]) * (1.f + sq[r][j]) + hq[r][j];
            if (ok[r]) store_row_bf16(C.xn() + (size_t)(row0 + r * NGW) * D, v[r], C.lane);
        }
    }
}
__device__ __forceinline__ void phase_final(const Ctx& C) {
    const int gw = C.vcu * NWAVES + C.wave, NGW = C.G * NWAVES;
    for (int row0 = gw; row0 < TL; row0 += 2 * NGW) {
        f32x4 v[2][4]; int sl[2][2]; bool ok[2]; int sm[2];
#pragma unroll
        for (int r = 0; r < 2; ++r) { const int row = row0 + r * NGW; ok[r] = row < TL; const int rw = ok[r] ? row : row0; sm[r] = rw >> 12;
            const v2u* hr = (const v2u*)C.hb(rw) + C.lane;
#pragma unroll
            for (int j = 0; j < 4; ++j) { const v2u w_ = hr[64 * j]; v[r][j] = (f32x4){bflo(w_.x), bfhi(w_.x), bflo(w_.y), bfhi(w_.y)}; }
            sl[r][0] = C.tok_slot()[2 * rw]; sl[r][1] = C.tok_slot()[2 * rw + 1]; }
        v2u y[2][2][4]; f32x4 gf[2][4];
#pragma unroll
        for (int r = 0; r < 2; ++r) { const f32x4* gp = (const f32x4*)(C.mods(1) + (size_t)sm[r] * 6144 + 5 * 1024) + C.lane;
#pragma unroll
            for (int k = 0; k < 2; ++k) { const v2u* y8 = (const v2u*)(C.ybuf() + (size_t)sl[r][k] * D) + C.lane;
#pragma unroll
                for (int j = 0; j < 4; ++j) y[r][k][j] = y8[64 * j]; }
#pragma unroll
            for (int j = 0; j < 4; ++j) gf[r][j] = gp[64 * j]; }
        const f32x4* fg = (const f32x4*)C.in[29] + C.lane; f32x4 fq[4];
#pragma unroll
        for (int j = 0; j < 4; ++j) fq[j] = fg[64 * j];
        asm volatile("" : "+v"(v[0][0]), "+v"(v[0][1]), "+v"(v[0][2]), "+v"(v[0][3]), "+v"(v[1][0]), "+v"(v[1][1]), "+v"(v[1][2]), "+v"(v[1][3]));
        asm volatile("" : "+v"(y[0][0][0]), "+v"(y[0][0][1]), "+v"(y[0][0][2]), "+v"(y[0][0][3]), "+v"(y[0][1][0]), "+v"(y[0][1][1]), "+v"(y[0][1][2]), "+v"(y[0][1][3]), "+v"(y[1][0][0]), "+v"(y[1][0][1]), "+v"(y[1][0][2]), "+v"(y[1][0][3]), "+v"(y[1][1][0]), "+v"(y[1][1][1]), "+v"(y[1][1][2]), "+v"(y[1][1][3]), "+v"(gf[0][0]), "+v"(gf[0][1]), "+v"(gf[0][2]), "+v"(gf[0][3]), "+v"(gf[1][0]), "+v"(gf[1][1]), "+v"(gf[1][2]), "+v"(gf[1][3]));
        asm volatile("" : "+v"(fq[0]), "+v"(fq[1]), "+v"(fq[2]), "+v"(fq[3]));
#pragma unroll
        for (int r = 0; r < 2; ++r) {
#pragma unroll
            for (int k = 0; k < 2; ++k)
#pragma unroll
                for (int j = 0; j < 4; ++j) { const v2u w = y[r][k][j]; v[r][j].x += gf[r][j].x * bflo(w.x); v[r][j].y += gf[r][j].y * bfhi(w.x); v[r][j].z += gf[r][j].z * bflo(w.y); v[r][j].w += gf[r][j].w * bfhi(w.y); }
            float ss = 0.f;
#pragma unroll
            for (int j = 0; j < 4; ++j) ss += (v[r][j].x * v[r][j].x + v[r][j].y * v[r][j].y) + (v[r][j].z * v[r][j].z + v[r][j].w * v[r][j].w);
            const float rstd = 1.f / sqrtf(wave_sum(ss) * (1.f / D) + 1e-6f);
            if (ok[r]) { f32x4* hr = (f32x4*)(C.outp() + (size_t)(row0 + r * NGW) * D) + C.lane;
#pragma unroll
                for (int j = 0; j < 4; ++j) hr[64 * j] = v[r][j] * rstd * fq[j]; }
        }
    }
}
#define DPPX(v, ctrl) __builtin_bit_cast(float, __builtin_amdgcn_update_dpp(0, __builtin_bit_cast(int, (v)), (ctrl), 0xf, 0xf, true))
#define SWZX(v, pat) __builtin_bit_cast(float, __builtin_amdgcn_ds_swizzle(__builtin_bit_cast(int, (v)), (pat)))
__device__ __forceinline__ void phase_norm2(const Ctx& C, int l) {
    const int gw = C.vcu * NWAVES + C.wave, NGW = C.G * NWAVES;
    const int ntok = (l == 0) ? T : TL;
    LAS int* hist = (LAS int*)(C.lds + LDSCTL_OFF) + 32;
    LAS float* wl = (LAS float*)C.lds;
    LAS float* lgs = (LAS float*)(C.lds + 65536) + C.wave * 16;
    if (C.tid < 16) hist[C.tid] = 0;
    for (int idx = C.tid; idx < 16384; idx += 512) wl[(idx & 15) * 1024 + (idx >> 4)] = C.in[24][idx];
    __syncthreads();
    const float* g = C.in[7] + l * D; const float* rb = C.in[25];
    const int lane = C.lane; const bool b0 = lane & 1, b1 = lane & 2, b2 = lane & 4, b3 = lane & 8;
    const int myexp = 8 * (lane & 1) + 4 * ((lane >> 1) & 1) + 2 * ((lane >> 2) & 1) + ((lane >> 3) & 1);
    const int gi = myexp >> 2, wi = myexp & 3; const float rbl = rb[myexp];
    for (int row = gw; row < ntok; row += NGW) {
        const int s = sample_of(row);
        f32x4 v[4], gq[4], sq[4], hq[4]; v2u hv[4]; const v2u* hr = (const v2u*)C.hb(row) + lane;
        const f32x4* gp = (const f32x4*)g + lane; const f32x4* shp = (const f32x4*)(C.mods(l) + (size_t)s * 6144 + 3 * 1024) + lane; const f32x4* scp = (const f32x4*)(C.mods(l) + (size_t)s * 6144 + 4 * 1024) + lane;
#pragma unroll
        for (int j = 0; j < 4; ++j) { hv[j] = hr[64 * j]; gq[j] = gp[64 * j]; sq[j] = scp[64 * j]; hq[j] = shp[64 * j]; }
        asm volatile("" : "+v"(hv[0]), "+v"(hv[1]), "+v"(hv[2]), "+v"(hv[3]), "+v"(gq[0]), "+v"(gq[1]), "+v"(gq[2]), "+v"(gq[3]), "+v"(sq[0]), "+v"(sq[1]), "+v"(sq[2]), "+v"(sq[3]), "+v"(hq[0]), "+v"(hq[1]), "+v"(hq[2]), "+v"(hq[3]));
#pragma unroll
        for (int j = 0; j < 4; ++j) v[j] = (f32x4){bflo(hv[j].x), bfhi(hv[j].x), bflo(hv[j].y), bfhi(hv[j].y)};
        float ss = 0.f;
#pragma unroll
        for (int j = 0; j < 4; ++j) ss += (v[j].x * v[j].x + v[j].y * v[j].y) + (v[j].z * v[j].z + v[j].w * v[j].w);
        const float rstd = 1.f / sqrtf(wave_sum(ss) * (1.f / D) + 1e-6f);
#pragma unroll
        for (int j = 0; j < 4; ++j) v[j] = (v[j] * rstd * gq[j]) * (1.f + sq[j]) + hq[j];
        store_row_bf16(C.xn() + (size_t)row * D, v, lane);
        float lg[16];
#pragma unroll
        for (int eg = 0; eg < 4; ++eg) {
            f32x4 w[16];
#pragma unroll
            for (int i = 0; i < 16; ++i) w[i] = *(const LAS f32x4*)(wl + (4 * eg + (i >> 2)) * 1024 + 256 * (i & 3) + 4 * lane);
            asm volatile("" : "+v"(w[0]), "+v"(w[1]), "+v"(w[2]), "+v"(w[3]), "+v"(w[4]), "+v"(w[5]), "+v"(w[6]), "+v"(w[7]), "+v"(w[8]), "+v"(w[9]), "+v"(w[10]), "+v"(w[11]), "+v"(w[12]), "+v"(w[13]), "+v"(w[14]), "+v"(w[15]));
#pragma unroll
            for (int e4 = 0; e4 < 4; ++e4) { typedef float f32x2 __attribute__((ext_vector_type(2))); f32x2 a2 = {0.f, 0.f};
#pragma unroll
                for (int j = 0; j < 4; ++j) { const f32x4 ww = w[4 * e4 + j]; a2 += (f32x2){v[j].x, v[j].y} * (f32x2){ww.x, ww.y}; a2 += (f32x2){v[j].z, v[j].w} * (f32x2){ww.z, ww.w}; }
                lg[4 * eg + e4] = a2.x + a2.y; } }
        float a8[8], a4[4], a2[2];
#pragma unroll
        for (int i = 0; i < 8; ++i) { const float send = b0 ? lg[i] : lg[i + 8], keep = b0 ? lg[i + 8] : lg[i]; a8[i] = keep + DPPX(send, 0xB1); }
#pragma unroll
        for (int i = 0; i < 4; ++i) { const float send = b1 ? a8[i] : a8[i + 4], keep = b1 ? a8[i + 4] : a8[i]; a4[i] = keep + DPPX(send, 0x4E); }
#pragma unroll
        for (int i = 0; i < 2; ++i) { const float send = b2 ? a4[i] : a4[i + 2], keep = b2 ? a4[i + 2] : a4[i]; a2[i] = keep + SWZX(send, 0x101F); }
        float a1; { const float send = b3 ? a2[0] : a2[1], keep = b3 ? a2[1] : a2[0]; a1 = keep + SWZX(send, 0x201F); }
        a1 += SWZX(a1, 0x401F);
        a1 = half_sum2(a1);
        { const float sg = 1.f / (1.f + expf(-a1)), bb = sg + rbl;
          const int la4 = (lane ^ 4) << 2, la8 = (lane ^ 8) << 2, la12 = (lane ^ 12) << 2;
#define BPERM(a, v) __builtin_bit_cast(float, __builtin_amdgcn_ds_bpermute((a), __builtin_bit_cast(int, (v))))
          const float v1 = BPERM(la4, bb), v2 = BPERM(la8, bb), v3 = BPERM(la12, bb);
          const float hi1 = fmaxf(bb, v1), lo1 = fminf(bb, v1), hi2 = fmaxf(v2, v3), lo2 = fminf(v2, v3);
          const float gs = fmaxf(hi1, hi2) + fmaxf(fminf(hi1, hi2), fmaxf(lo1, lo2));
          const float q1 = DPPX(gs, 0xB1), q2 = DPPX(gs, 0x4E), q3 = DPPX(gs, 0x1B);
          const bool best = (gs > q1 || (gs == q1 && gi < (gi ^ 2))) && (gs > q2 || (gs == q2 && gi < (gi ^ 1))) && (gs > q3 || (gs == q3 && gi < (gi ^ 3)));
          const int rank = ((v1 > bb || (v1 == bb && (wi ^ 2) < wi)) ? 1 : 0) + ((v2 > bb || (v2 == bb && (wi ^ 1) < wi)) ? 1 : 0) + ((v3 > bb || (v3 == bb && (wi ^ 3) < wi)) ? 1 : 0);
          const bool sel = best && rank < 2;
          const float ssel = sel ? sg : 0.f;
          const float gsum = (ssel + BPERM(la4, ssel)) + (BPERM(la8, ssel) + BPERM(la12, ssel));
#undef BPERM
          if (sel && lane < 16) { C.tok_e()[2 * row + rank] = myexp; C.tok_g()[2 * row + rank] = sg / gsum; atomicAdd((int*)(hist + myexp), 1); } }
    }
    __syncthreads();
    if (C.tid < 16) { const int n = hist[C.tid]; if (n) atomicAdd(C.ctl() + CW_CNT + l * 16 + C.tid, (unsigned)n); }
}
#undef DPPX
#undef SWZX
__device__ __forceinline__ void moe_tile_bases(const Ctx& C, int l) {
    LAS int* tb = (LAS int*)(C.lds + LDSCTL_OFF);
    __syncthreads();
    if (C.tid < 16) {
        const int n = (int)__hip_atomic_load(C.ctl() + CW_CNT + l * 16 + C.tid, __ATOMIC_RELAXED, __HIP_MEMORY_SCOPE_AGENT); const int t = (n + 255) >> 8; int x = t;
        x += __builtin_amdgcn_update_dpp(0, x, 0x111, 0xf, 0xf, true); x += __builtin_amdgcn_update_dpp(0, x, 0x112, 0xf, 0xf, true);
        x += __builtin_amdgcn_update_dpp(0, x, 0x114, 0xf, 0xf, true); x += __builtin_amdgcn_update_dpp(0, x, 0x118, 0xf, 0xf, true);
        tb[C.tid] = x - t; if (C.tid == 15) tb[16] = x; }
    __syncthreads();
}
__device__ __forceinline__ void phase_slot(const Ctx& C, int l) {
    const int ntok = (l == 0) ? T : TL;
    moe_tile_bases(C, l);
    const LAS int* tb = (const LAS int*)(C.lds + LDSCTL_OFF);
    LAS int* lcnt = (LAS int*)(C.lds + LDSCTL_OFF) + 32; LAS int* lbase = (LAS int*)(C.lds + LDSCTL_OFF) + 96;
    const int per = (ntok + C.G - 1) / C.G;
    for (int t0 = C.vcu * per; t0 < ntok; t0 += C.G * per) {
        if (C.tid < 16) lcnt[C.tid] = 0;
        __syncthreads();
        const int a = C.tid, t = t0 + (a >> 1); const bool ok = (a < 2 * per) && (t < ntok);
        int e = 0, rank = 0;
        if (ok) { e = C.tok_e()[2 * t + (a & 1)]; rank = atomicAdd((int*)(lcnt + e), 1); }
        __syncthreads();
        if (C.tid < 16) { const int n = lcnt[C.tid]; lbase[C.tid] = n ? (int)atomicAdd(C.ctl() + CW_CUR + l * 16 + C.tid, (unsigned)n) : 0; }
        __syncthreads();
        if (ok) { const int slot = tb[e] * 256 + lbase[e] + rank; C.tok_slot()[2 * t + (a & 1)] = slot; C.rowmap()[slot] = t; C.gslot()[slot] = C.tok_g()[2 * t + (a & 1)]; }
        __syncthreads();
    }
    if (C.vcu < 16) { const int e = C.vcu; const int n = (int)__hip_atomic_load(C.ctl() + CW_CNT + l * 16 + e, __ATOMIC_RELAXED, __HIP_MEMORY_SCOPE_AGENT); const int lo = tb[e] * 256 + n, hi = tb[e + 1] * 256;
        for (int i = lo + C.tid; i < hi; i += 512) { C.rowmap()[i] = 0; C.gslot()[i] = 0.f; } }
}

__device__ __forceinline__ void phase_prep(const Ctx& C, int l) {
    const int gw = C.vcu * NWAVES + C.wave, NGW = C.G * NWAVES;
    const float* cw = C.in[12] + (size_t)l * 3 * RC;
    { const int lane = C.lane;
      typedef unsigned u32x2 __attribute__((ext_vector_type(2)));
      f32x4 tap[3][8]; f32x4 kkw[2];
#pragma unroll
      for (int k3 = 0; k3 < 3; ++k3)
#pragma unroll
          for (int jb = 0; jb < 8; ++jb) tap[k3][jb] = *(const f32x4*)(cw + k3 * RC + 256 * jb + 4 * (jb == 7 ? (lane & 31) : lane));
#pragma unroll
      for (int jj = 0; jj < 2; ++jj) kkw[jj] = *(const f32x4*)(C.in[18] + l * RW + 256 * jj + 4 * lane);
      const int reg = lane < 16 ? 0 : lane < 32 ? 1 : lane < 40 ? 2 : lane < 48 ? 3 : lane < 56 ? 4 : 5;
      const float* qg = C.in[9] + l * 64; const float* kg = C.in[10] + l * 64;
      for (int row = gw; row < T; row += NGW) {
        const bool isc = row >= TL; const int len = isc ? 256 : 4096; const int pos = isc ? ((row - TL) & 255) : (row & 4095);
        const bool hp = pos > 0, hn = pos < len - 1;
        const bf16* u0 = C.ur() + (size_t)row * URP + 4 * lane; bf16* sp_ = C.sc() + (size_t)row * SCP + 4 * lane;
        u32x2 c1[8], c0[8], c2[8];
#pragma unroll
        for (int jb = 0; jb < 8; ++jb) c1[jb] = *(const u32x2*)(u0 + 256 * jb);
        if (hp) {
#pragma unroll
            for (int jb = 0; jb < 8; ++jb) c0[jb] = *(const u32x2*)(u0 - (long)URP + 256 * jb); }
        else {
#pragma unroll
            for (int jb = 0; jb < 8; ++jb) c0[jb] = (u32x2){0u, 0u}; }
        if (hn) {
#pragma unroll
            for (int jb = 0; jb < 8; ++jb) c2[jb] = *(const u32x2*)(u0 + (long)URP + 256 * jb); }
        else {
#pragma unroll
            for (int jb = 0; jb < 8; ++jb) c2[jb] = (u32x2){0u, 0u}; }
        float y[8][4];
#pragma unroll
        for (int jb = 0; jb < 8; ++jb) {
            y[jb][0] = tap[0][jb].x * bflo(c0[jb].x) + tap[1][jb].x * bflo(c1[jb].x) + tap[2][jb].x * bflo(c2[jb].x);
            y[jb][1] = tap[0][jb].y * bfhi(c0[jb].x) + tap[1][jb].y * bfhi(c1[jb].x) + tap[2][jb].y * bfhi(c2[jb].x);
            y[jb][2] = tap[0][jb].z * bflo(c0[jb].y) + tap[1][jb].z * bflo(c1[jb].y) + tap[2][jb].z * bflo(c2[jb].y);
            y[jb][3] = tap[0][jb].w * bfhi(c0[jb].y) + tap[1][jb].w * bfhi(c1[jb].y) + tap[2][jb].w * bfhi(c2[jb].y); }
#pragma unroll
        for (int jb = 0; jb < 6; ++jb) { u32x2 o; o.x = pk2(y[jb][0], y[jb][1]); o.y = pk2(y[jb][2], y[jb][3]); *(u32x2*)(sp_ + 256 * jb) = o; }
#pragma unroll
        for (int jj = 0; jj < 2; ++jj) {
            const float k0 = y[2 + jj][0] * kkw[jj].x, k1 = y[2 + jj][1] * kkw[jj].y, k2 = y[2 + jj][2] * kkw[jj].z, k3v = y[2 + jj][3] * kkw[jj].w;
            const float inv = 1.f / fmaxf(sqrtf(row_sum(k0 * k0 + k1 * k1 + k2 * k2 + k3v * k3v)), 1e-12f);
            u32x2 o; o.x = pk2(k0 * inv, k1 * inv); o.y = pk2(k2 * inv, k3v * inv); *(u32x2*)(sp_ + 3 * RW + 256 * jj) = o; }
        { u32x2 o; float z[4];
#pragma unroll
          for (int e = 0; e < 4; ++e) { const float th = 1.f - 2.f * __builtin_amdgcn_rcpf(__expf(2.f * y[6][e]) + 1.f); z[e] = lane < 32 ? th : y[6][e]; }
          o.x = pk2(z[0], z[1]); o.y = pk2(z[2], z[3]); *(u32x2*)(sp_ + 2560) = o;
          if (lane < 32) {
#pragma unroll
              for (int e = 0; e < 4; ++e) z[e] = 1.f / (1.f + __expf(-y[7][e]));
              o.x = pk2(z[0], z[1]); o.y = pk2(z[2], z[3]); *(u32x2*)(C.sgd() + (size_t)row * 128 + 4 * lane) = o; } }
        if (reg != 3 && reg != 5) {
        bf16* p = C.qkv() + (size_t)row * D + 16 * lane;
        const v4u w0 = *(const v4u*)p, w1 = *(const v4u*)(p + 8);
        float x[16];
        x[0] = bflo(w0.x); x[1] = bfhi(w0.x); x[2] = bflo(w0.y); x[3] = bfhi(w0.y); x[4] = bflo(w0.z); x[5] = bfhi(w0.z); x[6] = bflo(w0.w); x[7] = bfhi(w0.w);
        x[8] = bflo(w1.x); x[9] = bfhi(w1.x); x[10] = bflo(w1.y); x[11] = bfhi(w1.y); x[12] = bflo(w1.z); x[13] = bfhi(w1.z); x[14] = bflo(w1.w); x[15] = bfhi(w1.w);
        const int hc0 = (16 * lane) & 63;
        if (reg == 0 || reg == 2) { float ss = 0.f;
#pragma unroll
            for (int i = 0; i < 16; ++i) ss += x[i] * x[i];
            ss = quad_sum(ss);
            const float rstd = 1.f / sqrtf(ss * (1.f / 64.f) + 1e-6f); const float* gg = (reg == 0 ? qg : kg) + hc0;
#pragma unroll
            for (int i = 0; i < 16; ++i) x[i] = x[i] * rstd * gg[i]; }
        if (row < TL) { const int pos = row & 4095; const float* cp = C.ropec() + pos * 32 + (hc0 >> 1); const float* sp = C.ropes() + pos * 32 + (hc0 >> 1);
#pragma unroll
            for (int i = 0; i < 8; ++i) { const float c = cp[i], s = sp[i], a = x[2 * i], b = x[2 * i + 1]; x[2 * i] = a * c - b * s; x[2 * i + 1] = a * s + b * c; } }
        if (reg < 2) {
#pragma unroll
            for (int i = 0; i < 16; ++i) x[i] *= C2; }
        v4u o0, o1; o0.x = pk2(x[0], x[1]); o0.y = pk2(x[2], x[3]); o0.z = pk2(x[4], x[5]); o0.w = pk2(x[6], x[7]); o1.x = pk2(x[8], x[9]); o1.y = pk2(x[10], x[11]); o1.z = pk2(x[12], x[13]); o1.w = pk2(x[14], x[15]);
        *(v4u*)p = o0; *(v4u*)(p + 8) = o1;
        }
      } }
}

__device__ __forceinline__ int scan_row(int bb, int dir, int n) {
    if (dir == 0) return n < 256 ? TL + bb * 256 + n : bb * 4096 + (n - 256);
    return n < 256 ? TL + bb * 256 + (255 - n) : bb * 4096 + (4095 - (n - 256));
}
__device__ __forceinline__ void phase_attn(const Ctx& C, int l, int pass, bool isA) {
    typedef attn_body::bf16 abf;
    if (isA ? (C.vcu >= 64) : (C.vcu < 64)) return;
    __syncthreads();
    char* shm = (char*)C.lds;
    const abf* Q = (const abf*)C.qkv();
    const int a = C.vcu - 64;
#pragma unroll 1
    for (int i = 0; i < 2; ++i) {
        int u;
        if (i == 0) u = isA ? 2 * (192 + C.vcu) + pass : 2 * a + pass;
        else { if (isA || l != 0 || a >= 32) continue; u = 512 + 2 * a + pass; }
        if (u < 512) { const int b = u >> 6, h = (u >> 4) & 3, qb = u & 15;
            attn_body::attn_unit<8, 0>(Q + ((size_t)b * 4096 + qb * 256) * D + h * 64, Q + 512 + (h >> 1) * 64, Q + 640 + (h >> 1) * 64, TL + b * 256, b * 4096, 68, 0, -INFINITY, shm, C.tid); }
        else { const int x = u - 512, win = x >> 5, b = (x >> 2) & 7, h = x & 3;
            attn_body::attn_unit<8, 0>(Q + ((size_t)TL + b * 256) * D + win * 256 + h * 64, Q + (win ? 768 : 512) + (h >> 1) * 64, Q + (win ? 896 : 640) + (h >> 1) * 64, TL + b * 256, 0, 4, 0,
                                       win ? C.in[11][l * 4 + h] * LOG2E : -INFINITY, shm, C.tid); }
    }
    if (!isA && a >= 64) {
#pragma unroll 1
        for (int i = 0; i < 2; ++i) { const int u = 2 * (2 * (a - 64) + i) + pass; const int b = u >> 6, h = (u >> 4) & 3, qb = u & 15;
            const int lo = (4 * qb - 2 < 0) ? 0 : 4 * qb - 2, hi = (4 * qb + 5 > 63) ? 63 : 4 * qb + 5;
            attn_body::attn_unit<8, 1>(Q + ((size_t)b * 4096 + qb * 256) * D + 256 + h * 64, Q + 768 + (h >> 1) * 64, Q + 896 + (h >> 1) * 64, TL + b * 256, b * 4096 + 64 * lo, 4 + (hi - lo + 1), 64 * lo - 256 * qb,
                                       C.in[11][l * 4 + h] * LOG2E, shm, C.tid); }
    }
}
__device__ __forceinline__ void phase_scanA(const Ctx& C, int l, int d) {
    const int gw = C.vcu * NWAVES + C.wave, NGW = C.G * NWAVES;
    LAS unsigned char* tile = C.lds + C.wave * 5120; LAS float* gam = (LAS float*)(tile + rs::TILE_BYTES);
    const int tbase = C.vcu < 64 ? C.vcu * 16 : 1024 + (C.vcu - 64) * 40, tend = tbase + (C.vcu < 64 ? 16 : 40);
    const int ch0 = tbase / rs::NCHUNK;
    __syncthreads();
    for (int p = C.tid; p < 2 * 2 * 512; p += 512) { const int s2 = p >> 10, which = (p >> 9) & 1, rw = (p >> 3) & 63, pc = p & 7; const int hh = (ch0 + s2) & 7;
        const bf16* src = (which ? C.a2t(l, d) : C.w2t(l, d)) + (size_t)(64 * hh + rw) * 64 + pc * 8;
        *(LAS v4u*)(C.lds + 40960 + s2 * 18432 + which * 9216 + (rw * 72 + pc * 8) * 2) = *(const v4u*)src; }
    __syncthreads();
#pragma unroll 1
    for (int task = tbase + C.wave; task < tend; task += NWAVES) {
        const int ch = task / rs::NCHUNK, ci = task - ch * rs::NCHUNK, b = ch >> 3, h = ch & 7;
        const int row0 = scan_row(b, d, 32 * ci);
        const rs::ChunkIn in{C.sc() + (size_t)row0 * SCP + h * 64, d ? -(long)SCP : (long)SCP, C.sc() + (size_t)row0 * SCP + 2560};
        const LAS unsigned char* limg = C.lds + 40960 + (ch - ch0) * 18432;
        const rs::LoraIn lo{limg, limg + 9216, C.in[13] + (l * 2 + d) * RW + 64 * h, C.in[15] + (l * 2 + d) * RW + 64 * h, C.sc() + (size_t)row0 * SCP + 3072 + d * RW + h * 64};
        const int lane = fresh_lane();
        float zf; asm volatile("v_mov_b32 %0, 0" : "=v"(zf));
        const float ka = C.in[19][l * RW + h * 64 + lane];
        rs::passA_chunk(in, lo, d, ka, tile, gam, C.wsp() + WS_SCD + (size_t)task * 16384, C.wsp() + WS_STF + (size_t)task * 8192, lane, zf);
    }
}
__device__ __forceinline__ void phase_scanB(const Ctx& C, int d) {
    if (C.vcu >= 64) return;
    constexpr int NS = 5, AHEAD = 4, SLOT = 24576, XB = NS * SLOT;
    const int lane = C.lane, w = C.wave, chain = C.vcu, tj = (w >> 1) & 1, tv = w & 1; const bool comp = w < 4, outw = (w == 4 || w == 5), dmaw = !outw; const int sw = w < 4 ? w : w - 2;
    const int hi = lane >> 5, l31 = lane & 31, b = chain >> 3, h = chain & 7;
    float zf; asm volatile("v_mov_b32 %0, 0" : "=v"(zf));
    rs::f32x16 aS = rs::zero16(zf);
    const unsigned char* dump = C.wsp() + WS_SCD + (size_t)(chain * rs::NCHUNK) * 16384;
    const unsigned char* dump2 = C.wsp() + WS_STF + (size_t)(chain * rs::NCHUNK) * 8192;
    const unsigned ldsb = (unsigned)(uintptr_t)C.lds;
#define SB_DMA(c) do { if (dmaw) { const int c_ = (c) < rs::NCHUNK ? (c) : rs::NCHUNK - 1; const unsigned sl_ = (unsigned)((c) % NS) * (unsigned)SLOT; \
        _Pragma("unroll") for (int i_ = 0; i_ < 4; ++i_) { const int p_ = 4 * sw + i_; \
            const unsigned char* src_ = p_ < 16 ? dump + (size_t)c_ * 16384 + p_ * 1024 : dump2 + (size_t)c_ * 8192 + (p_ - 16) * 1024; \
            pg8::glds16s(src_, (unsigned)(lane * 16), (unsigned)__builtin_amdgcn_readfirstlane((int)(ldsb + sl_ + p_ * 1024))); } } } while (0)
#pragma unroll 1
    for (int c = 0; c < AHEAD; ++c) SB_DMA(c);
    asm volatile("s_waitcnt vmcnt(0)" ::: "memory");
#pragma unroll 1
    for (int ci = 0; ci < rs::NCHUNK; ++ci) {
        LAS unsigned char* xw = C.lds + XB + (ci & 1) * 8192; LAS unsigned char* rg = C.lds + (ci % NS) * SLOT;
        if (comp) { const rs::bf16x8 p0 = rs::packq(aS, 0), p1 = rs::packq(aS, 1);
            *(LAS rs::bf16x8*)(xw + w * 2048 + lane * 16) = p0; *(LAS rs::bf16x8*)(xw + w * 2048 + 1024 + lane * 16) = p1; }
        if (dmaw) asm volatile("s_waitcnt vmcnt(12) lgkmcnt(0)\n\ts_barrier" ::: "memory");
        else asm volatile("s_waitcnt lgkmcnt(0)\n\ts_barrier" ::: "memory");
        if (comp) {
            rs::bf16x8 g0 = *(const LAS rs::bf16x8*)(rg + (8 + w * 2) * 1024 + lane * 16), g1 = *(const LAS rs::bf16x8*)(rg + (8 + w * 2 + 1) * 1024 + lane * 16), fm[4], fx[4];
#pragma unroll
            for (int i = 0; i < 4; ++i) { fm[i] = *(const LAS rs::bf16x8*)(rg + (((i >> 1) * 2 + tj) * 2 + (i & 1)) * 1024 + lane * 16); fx[i] = *(const LAS rs::bf16x8*)(xw + ((i >> 1) * 2 + tv) * 2048 + (i & 1) * 1024 + lane * 16); }
            asm volatile("" : "+v"(g0), "+v"(g1), "+v"(fm[0]), "+v"(fm[1]), "+v"(fm[2]), "+v"(fm[3]), "+v"(fx[0]), "+v"(fx[1]), "+v"(fx[2]), "+v"(fx[3]));
            rs::f32x16 a = rs::unpack16(g0, g1);
#pragma unroll
            for (int i = 0; i < 4; ++i) a = rs::mf(fm[i], fx[i], a);
            aS = a; }
        if (outw) { const int ov = w - 4;
            rs::bf16x8 g0 = *(const LAS rs::bf16x8*)(rg + (16 + 4 + ov * 2) * 1024 + lane * 16), g1 = *(const LAS rs::bf16x8*)(rg + (16 + 4 + ov * 2 + 1) * 1024 + lane * 16), fm[4], fx[4];
#pragma unroll
            for (int i = 0; i < 4; ++i) { fm[i] = *(const LAS rs::bf16x8*)(rg + (16 + (i >> 1) * 2 + (i & 1)) * 1024 + lane * 16); fx[i] = *(const LAS rs::bf16x8*)(xw + ((i >> 1) * 2 + ov) * 2048 + (i & 1) * 1024 + lane * 16); }
            asm volatile("" : "+v"(g0), "+v"(g1), "+v"(fm[0]), "+v"(fm[1]), "+v"(fm[2]), "+v"(fm[3]), "+v"(fx[0]), "+v"(fx[1]), "+v"(fx[2]), "+v"(fx[3]));
            rs::f32x16 a = rs::unpack16(g0, g1);
#pragma unroll
            for (int i = 0; i < 4; ++i) a = rs::mf(fm[i], fx[i], a);
            const int row0 = scan_row(b, d, 32 * ci); const long rs_ = d ? -(long)SCP : (long)SCP;
            bf16* o0 = C.sc() + (size_t)row0 * SCP + 2048 + d * RW + h * 64 + 32 * ov + l31;
#pragma unroll
            for (int r = 0; r < 16; r += 2) { const unsigned p = rs::pk(a[r], a[r + 1]);
                o0[(long)rs::crow(r, hi) * rs_] = (bf16)(p & 0xffffu); o0[(long)rs::crow(r + 1, hi) * rs_] = (bf16)(p >> 16); } }
        asm volatile("s_waitcnt lgkmcnt(0)" ::: "memory");
        SB_DMA(ci + AHEAD);
    }
    asm volatile("s_waitcnt vmcnt(0)" ::: "memory");
#undef SB_DMA
}
__device__ __forceinline__ void phase_rwkvout(const Ctx& C, int l) {
    typedef rs::bf16x8 bx8; typedef rs::f32x16 fx16;
    const int ntile = ((l == 0) ? T : TL) / 32;
    const int chh = (C.vcu & 1) * 256;
    __syncthreads();
    { const bf16* g2s = C.g2t(l) + (size_t)chh * 128;
      for (int p = C.tid; p < 256 * 16; p += 512) { const int rw = p >> 4, pc = p & 15; *(LAS v4u*)(C.lds + (rw * 136 + pc * 8) * 2) = *(const v4u*)(g2s + (size_t)rw * 128 + pc * 8); }
      for (int p = C.tid; p < 5 * 256; p += 512) { const int which = p >> 8, c = chh + (p & 255);
          const float* src = which == 0 ? C.in[21] + l * RW : which == 1 ? C.in[22] + l * RW : which == 2 ? C.in[19] + l * RW : C.in[20] + (l * 2 + (which - 3)) * RW;
          *(LAS float*)(C.lds + 69632 + p * 4) = src[c]; } }
    __syncthreads();
    const int wv = (C.vcu >> 1) * NWAVES + C.wave, NWV = (C.G >> 1) * NWAVES;
    float zf; asm volatile("v_mov_b32 %0, 0" : "=v"(zf));
    const LAS float* prm = (const LAS float*)(C.lds + 69632);
    for (int task = wv; task < ntile * 4; task += NWV) {
        int ln = C.lane; asm volatile("" : "+v"(ln));
        const int tt = task >> 2, hl = task & 3;
        const int t = ln & 31, hi = ln >> 5; const int row = tt * 32 + t;
        const bf16* sp = C.sc() + (size_t)row * SCP;
        const int arow = 16 * ((t >> 3) >> 1) + 8 * ((t >> 2) & 1) + 4 * ((t >> 3) & 1) + (t & 3);
        const int hd = (chh >> 6) + hl; const int cb = 64 * hd + 8 * hi, cl = 64 * hl + 8 * hi;
        v4u f[4], b[4], vv[4], rr[4], kk[4], a0[4], a1[4]; bx8 sg[8];
#pragma unroll
        for (int i = 0; i < 4; ++i) { const int c0 = cb + 16 * i; f[i] = *(const v4u*)(sp + 2048 + c0); b[i] = *(const v4u*)(sp + 2048 + RW + c0); vv[i] = *(const v4u*)(sp + 2 * RW + c0); }
#pragma unroll
        for (int q = 0; q < 8; ++q) sg[q] = __builtin_bit_cast(bx8, *(const v4u*)(C.sgd() + (size_t)row * 128 + 16 * q + 8 * hi));
#pragma unroll
        for (int i = 0; i < 4; ++i) { const int c0 = cb + 16 * i; rr[i] = *(const v4u*)(sp + c0); kk[i] = *(const v4u*)(sp + RW + c0); a0[i] = *(const v4u*)(sp + 3072 + c0); a1[i] = *(const v4u*)(sp + 3072 + RW + c0); }
        asm volatile("" : "+v"(f[0]), "+v"(f[1]), "+v"(f[2]), "+v"(f[3]), "+v"(b[0]), "+v"(b[1]), "+v"(b[2]), "+v"(b[3]), "+v"(vv[0]), "+v"(vv[1]), "+v"(vv[2]), "+v"(vv[3]),
                     "+v"(sg[0]), "+v"(sg[1]), "+v"(sg[2]), "+v"(sg[3]), "+v"(sg[4]), "+v"(sg[5]), "+v"(sg[6]), "+v"(sg[7]));
        float on[4][8]; float s1 = zf;
#pragma unroll
        for (int i = 0; i < 4; ++i) { const v4u ff = f[i], bb = b[i];
            on[i][0] = bflo(ff.x) + bflo(bb.x); on[i][1] = bfhi(ff.x) + bfhi(bb.x); on[i][2] = bflo(ff.y) + bflo(bb.y); on[i][3] = bfhi(ff.y) + bfhi(bb.y);
            on[i][4] = bflo(ff.z) + bflo(bb.z); on[i][5] = bfhi(ff.z) + bfhi(bb.z); on[i][6] = bflo(ff.w) + bflo(bb.w); on[i][7] = bfhi(ff.w) + bfhi(bb.w);
#pragma unroll
            for (int e = 0; e < 8; ++e) s1 += on[i][e]; }
        const float mu = half_sum2(s1) * (1.f / 64.f); float s2 = zf;
#pragma unroll
        for (int i = 0; i < 4; ++i)
#pragma unroll
            for (int e = 0; e < 8; ++e) { const float dv = on[i][e] - mu; on[i][e] = dv; s2 += dv * dv; }
        const float rstd = 1.f / sqrtf(half_sum2(s2) * (1.f / 64.f) + 64e-5f);
        asm volatile("" : "+v"(rr[0]), "+v"(rr[1]), "+v"(rr[2]), "+v"(rr[3]), "+v"(kk[0]), "+v"(kk[1]), "+v"(kk[2]), "+v"(kk[3]), "+v"(a0[0]), "+v"(a0[1]), "+v"(a0[2]), "+v"(a0[3]), "+v"(a1[0]), "+v"(a1[1]), "+v"(a1[2]), "+v"(a1[3]));
        float bsum = zf;
#pragma unroll
        for (int i = 0; i < 4; ++i) {
            f32x4 pw[10];
#pragma unroll
            for (int hf = 0; hf < 2; ++hf)
#pragma unroll
                for (int p = 0; p < 5; ++p) pw[hf * 5 + p] = *(const LAS f32x4*)(prm + p * 256 + cl + 16 * i + 4 * hf);
            asm volatile("" : "+v"(pw[0]), "+v"(pw[1]), "+v"(pw[2]), "+v"(pw[3]), "+v"(pw[4]), "+v"(pw[5]), "+v"(pw[6]), "+v"(pw[7]), "+v"(pw[8]), "+v"(pw[9]));
            const v4u rr_ = rr[i], kk_ = kk[i], a0_ = a0[i], a1_ = a1[i];
            const float rv[8] = {bflo(rr_.x), bfhi(rr_.x), bflo(rr_.y), bfhi(rr_.y), bflo(rr_.z), bfhi(rr_.z), bflo(rr_.w), bfhi(rr_.w)}, kv[8] = {bflo(kk_.x), bfhi(kk_.x), bflo(kk_.y), bfhi(kk_.y), bflo(kk_.z), bfhi(kk_.z), bflo(kk_.w), bfhi(kk_.w)};
            const float a0v[8] = {bflo(a0_.x), bfhi(a0_.x), bflo(a0_.y), bfhi(a0_.y), bflo(a0_.z), bfhi(a0_.z), bflo(a0_.w), bfhi(a0_.w)}, a1v[8] = {bflo(a1_.x), bfhi(a1_.x), bflo(a1_.y), bfhi(a1_.y), bflo(a1_.z), bfhi(a1_.z), bflo(a1_.w), bfhi(a1_.w)};
#pragma unroll
            for (int hf = 0; hf < 2; ++hf) { const f32x4 lw = pw[hf * 5], lb = pw[hf * 5 + 1], ka = pw[hf * 5 + 2], rk0 = pw[hf * 5 + 3], rk1 = pw[hf * 5 + 4];
#pragma unroll
                for (int e = 0; e < 4; ++e) { const int e8 = 4 * hf + e; on[i][e8] = on[i][e8] * rstd * lw[e] + lb[e];
                    bsum += rv[e8] * kv[e8] * ((1.f + (a0v[e8] - 1.f) * ka[e]) * rk0[e] + (1.f + (a1v[e8] - 1.f) * ka[e]) * rk1[e]); } } }
        const float bonus = half_sum2(bsum);
#pragma unroll
        for (int ctl = 0; ctl < 2; ++ctl) {
            bx8 gq[8];
#pragma unroll
            for (int q = 0; q < 8; ++q) gq[q] = *(const LAS bx8*)(C.lds + ((64 * hl + 32 * ctl + arow) * 136 + 16 * q + 8 * hi) * 2);
            asm volatile("" : "+v"(gq[0]), "+v"(gq[1]), "+v"(gq[2]), "+v"(gq[3]), "+v"(gq[4]), "+v"(gq[5]), "+v"(gq[6]), "+v"(gq[7]));
            fx16 ag = rs::zero16(zf);
#pragma unroll
            for (int q = 0; q < 8; ++q) ag = rs::mf(gq[q], sg[q], ag);
#pragma unroll
            for (int a2 = 0; a2 < 2; ++a2) { const int i = 2 * ctl + a2; const v4u v_ = vv[i];
                const float v8[8] = {bflo(v_.x), bfhi(v_.x), bflo(v_.y), bfhi(v_.y), bflo(v_.z), bfhi(v_.z), bflo(v_.w), bfhi(v_.w)}; float o8[8];
#pragma unroll
                for (int e = 0; e < 8; ++e) o8[e] = (on[i][e] + bonus * v8[e]) * ag[8 * a2 + e];
                v4u po; po.x = rs::pk(o8[0], o8[1]); po.y = rs::pk(o8[2], o8[3]); po.z = rs::pk(o8[4], o8[5]); po.w = rs::pk(o8[6], o8[7]);
                *(v4u*)(C.qkv() + (size_t)row * D + 512 + cb + 16 * i) = po; }
        }
    }
}

constexpr int NPL = 13;
constexpr int NPH = 1 + DEPTH * NPL + 1;

__global__ void __launch_bounds__(NWAVES * 64, 2) mega_fwd(Args args) {
    extern __shared__ __attribute__((aligned(16))) unsigned char lds[];
    Ctx C;
    C.out = (__attribute__((address_space(1))) float*)args.out; C.ws = (__attribute__((address_space(1))) unsigned char*)args.ws;
    C.lds = (LAS unsigned char*)lds; C.tid = threadIdx.x; C.lane = C.tid & 63; C.wave = __builtin_amdgcn_readfirstlane(C.tid >> 6);
    C.G = gridDim.x; { const int bx = blockIdx.x; C.vcu = (C.G % 8 == 0) ? (bx % 8) * (C.G / 8) + bx / 8 : bx; }
    for (int u = C.tid; u < (LDS_BYTES - LDSCTL_OFF) / 4; u += NWAVES * 64) ((LAS unsigned*)(C.lds + LDSCTL_OFF))[u] = 0u;
    __syncthreads();
    XcdBarrier bar; bar.bar = C.ctl() + CW_BAR; bar.x = 0; bar.st = nullptr;
    if (args.use_bar) bar = xcd_barrier_post(C.ctl() + CW_BAR, (volatile LAS unsigned*)(C.lds + LDSCTL_OFF) + 56, C.tid);
    const int lo = args.ph_lo, hi = args.ph_hi;
    unsigned ldsv = (unsigned)(uintptr_t)C.lds;
    int wave_s = C.wave;
#define FRESH() { int z_; asm volatile("s_mov_b32 %0, 0" : "=s"(z_)); asm volatile("" : "+s"(C.ws), "+s"(C.out), "+s"(wave_s), "+s"(C.vcu), "+s"(C.G), "+s"(ldsv)); C.lds = (LAS unsigned char*)(uintptr_t)ldsv; \
    C.lane = (int)__builtin_amdgcn_mbcnt_hi(~0u, __builtin_amdgcn_mbcnt_lo(~0u, (unsigned)z_)); C.wave = wave_s; C.tid = (wave_s << 6) | C.lane; }
#define IN(k) (lo <= (k) && (k) < hi)
#define SEAM(k) do { if ((lo <= (k) && (k) < hi) && (lo <= (k) + 1 && (k) + 1 < hi)) { if (args.use_bar) xcd_barrier(bar, C.tid); } } while (0)

    int ph = 0;
#define PH_BEGIN FRESH() if (IN(ph)) {
#define PH_END } SEAM(ph); ++ph;
    PH_BEGIN phase_prologue(C); PH_END
#pragma unroll 1
    for (int l = 0; l < DEPTH; ++l) {
        PH_BEGIN phase_norm1(C, l); PH_END
        PH_BEGIN
            pg8::Gemm g{C.xn(), C.w_in_t(l), T, INP, D, nullptr}; pg8::StaticOrder S; S.init(T, INP, C.G, (int)blockIdx.x);
            EpiIn E{C.qkv(), C.ur()};
            pg8::gemm_phase<EpiIn, pg8::StaticOrder, true, false>(C.lds, g, S, E, C.tid);
        PH_END
        PH_BEGIN phase_prep(C, l); PH_END
#pragma unroll 1
        for (int sp = 0; sp < 4; ++sp) {
            const int d = sp >> 1; const bool isA = !(sp & 1);
            PH_BEGIN
                if (isA) phase_scanA(C, l, d); else if (C.vcu < 64) phase_scanB(C, d);
                FRESH()
                phase_attn(C, l, d, isA);
            PH_END
        }
        PH_BEGIN phase_rwkvout(C, l); PH_END
        PH_BEGIN
            const int Mo = (l == 0) ? T : TL;
            pg8::Gemm g{C.qkv(), C.w_out_t(l), Mo, D, D, nullptr}; pg8::StaticOrder S; S.init(Mo, D, C.G, (int)blockIdx.x);
            EpiOut E{C.hb(0), C.hb(TL), C.mods(l) + 2 * 1024};
            pg8::gemm_phase<EpiOut, pg8::StaticOrder, true, false>(C.lds, g, S, E, C.tid);
            phase_wconv(C, l);
        PH_END
        PH_BEGIN phase_norm2(C, l); PH_END
        PH_BEGIN phase_slot(C, l); PH_END
        PH_BEGIN
            moe_tile_bases(C, l);
            const LAS int* tb = (const LAS int*)(C.lds + LDSCTL_OFF); LAS int* rmc = (LAS int*)(C.lds + RMC_OFF);
            pg8::MoeOrder S; S.init(tb[16], 8, C.G, (int)blockIdx.x, tb);
            { pg8::Unit u; for (int i = 0; S.next(i, u) && i < 12; ++i) if (C.tid < 256) rmc[i * 256 + C.tid] = C.rowmap()[u.pm * 256 + C.tid]; }
            __syncthreads();
            pg8::Gemm g{C.xn(), C.wgu(), tb[16] * 256, 2048, D, rmc};
            EpiGU E{C.hmid()};
            pg8::gemm_phase<EpiGU, pg8::MoeOrder, true, true>(C.lds, g, S, E, C.tid);
        PH_END
        PH_BEGIN
            moe_tile_bases(C, l);
            const LAS int* tb = (const LAS int*)(C.lds + LDSCTL_OFF);
            pg8::MoeOrder S; S.init(tb[16], 4, C.G, (int)blockIdx.x, tb);
            pg8::Gemm g{C.hmid(), C.wdn(), tb[16] * 256, 1024, D, nullptr};
            EpiDN E{C.ybuf(), C.gslot()};
            pg8::gemm_phase<EpiDN, pg8::MoeOrder, true, false>(C.lds, g, S, E, C.tid);
        PH_END
    }
    PH_BEGIN phase_final(C); PH_END
#undef PH_BEGIN
#undef PH_END
#undef IN
#undef SEAM
}

extern "C" void kernel_launch(void* const* d_in, const int* in_sizes, int n_in, void* d_out, int out_size, void* d_ws, size_t ws_size, hipStream_t stream) {
    static int grid = 0;
    if (grid == 0) {
        if (n_in != 30 || out_size != TL * D || ws_size < WS_END) { fprintf(stderr, "kernel_launch: unexpected shapes: n_in %d out %d ws %zu (need %zu)\n", n_in, out_size, ws_size, (size_t)WS_END); grid = -1; return; }
        int dev = 0, cus = 0, per_cu = 0;
        if (hipGetDevice(&dev) != hipSuccess || hipDeviceGetAttribute(&cus, hipDeviceAttributeMultiprocessorCount, dev) != hipSuccess) { grid = -1; return; }
        if (hipFuncSetAttribute((const void*)mega_fwd, hipFuncAttributeMaxDynamicSharedMemorySize, LDS_BYTES) != hipSuccess) { fprintf(stderr, "kernel_launch: hipFuncSetAttribute failed\n"); grid = -1; return; }
        if (hipOccupancyMaxActiveBlocksPerMultiprocessor(&per_cu, (const void*)mega_fwd, NWAVES * 64, LDS_BYTES) != hipSuccess || per_cu < 1) { fprintf(stderr, "kernel_launch: occupancy query says %d\n", per_cu); }
        (void)hipGetLastError();
        grid = cus;
    }
    if (grid < 0) return;
    if (hipMemsetAsync((char*)d_ws + WS_CTL, 0, CTL_ZERO_BYTES, stream) != hipSuccess) return;
    Args a{};
    for (int i = 0; i < 30; ++i) a.in[i] = (const float*)d_in[i];
    a.out = (float*)d_out; a.ws = (unsigned char*)d_ws;
#if MK_PER_PHASE
    for (int p = 0; p < NPH; ++p) { a.ph_lo = p; a.ph_hi = p + 1; a.use_bar = 0; hipLaunchKernelGGL(mega_fwd, dim3(grid), dim3(NWAVES * 64), LDS_BYTES, stream, a); }
#else
    a.ph_lo = 0; a.ph_hi = NPH; a.use_bar = 1;
    hipLaunchKernelGGL(mega_fwd, dim3(grid), dim3(NWAVES * 64), LDS_BYTES, stream, a);
#endif
}
```

```cpp
#include <hip/hip_runtime.h>
#include <cstdio>
#include <cstdint>

#ifndef MK_PER_PHASE
#define MK_PER_PHASE 0
#endif

namespace pg8 {
#define PG8_LAS __attribute__((address_space(3)))
typedef unsigned short bf16_t;
typedef short bf16x8 __attribute__((ext_vector_type(8)));
typedef float f32x4 __attribute__((ext_vector_type(4)));
typedef unsigned u32x4 __attribute__((ext_vector_type(4)));
constexpr int BM = 256, BK = 64, HALF = 128, HTB = HALF * BK * 2, STAGE_BYTES = 8 * HTB, NXCD = 8, WGM = 8;

__host__ __device__ __forceinline__ int lds_byte(int r, int c) { const int st = (r >> 4) * 2 + (c >> 5), rr = r & 15, cc = c & 31, ob = rr * 64 + cc * 2; return st * 1024 + (ob ^ (((ob >> 9) & 1) << 5)); }
__host__ __device__ __forceinline__ void stage_rc(int b, int& R, int& C) { const int st = b / 1024, sb = b % 1024, swz = sb ^ (((sb >> 9) & 1) << 5); R = (st >> 1) * 16 + swz / 64; C = (st & 1) * 32 + (swz % 64) / 2; }
__host__ __device__ __forceinline__ int perm32(int rho) { const int n = rho >> 4, i = rho & 15; return 8 * (i >> 2) + 4 * n + (i & 3); }

struct Unit { int pm, pn; };
struct Gemm { const bf16_t* A; const bf16_t* Bt; int M, N, K; const PG8_LAS int* rmc; };

struct StaticOrder {
    int nM, nN, nwg, G, c;
    __host__ __device__ __forceinline__ void init(int M, int N, int G_, int c_) { nM = M / BM; nN = N / BM; nwg = nM * nN; G = G_; c = c_; }
    __host__ __device__ __forceinline__ bool next(int i, Unit& u) const {
        const long L = (long)i * G + c; if (L >= nwg) return false;
        int wgid = (int)L; { const int q = nwg / NXCD, r = nwg % NXCD, xcd = wgid % NXCD, off = wgid / NXCD; wgid = (xcd < r ? xcd * (q + 1) : r * (q + 1) + (xcd - r) * q) + off; }
        const int nig = WGM * nN, gid = wgid / nig, fm = gid * WGM, gsz = (nM - fm) < WGM ? (nM - fm) : WGM;
        u.pm = fm + ((wgid % nig) % gsz); u.pn = (wgid % nig) / gsz; return true;
    }
};
struct MoeOrder {
    int nM, nN, nwg, G, c; const PG8_LAS int* tb;
    __device__ __forceinline__ void init(int nM_, int nN_, int G_, int c_, const PG8_LAS int* tb_) { nM = nM_; nN = nN_; nwg = nM * nN; G = G_; c = c_; tb = tb_; }
    __device__ __forceinline__ bool next(int i, Unit& u) const {
        const long L = (long)i * G + c; if (L >= nwg) return false;
        int wgid = (int)L; { const int q = nwg / NXCD, r = nwg % NXCD, xcd = wgid % NXCD, off = wgid / NXCD; wgid = (xcd < r ? xcd * (q + 1) : r * (q + 1) + (xcd - r) * q) + off; }
        const int nig = WGM * nN, gid = wgid / nig, fm = gid * WGM, gsz = (nM - fm) < WGM ? (nM - fm) : WGM;
        const int pm = fm + ((wgid % nig) % gsz), pnl = (wgid % nig) / gsz;
        int e = 0;
#pragma unroll
        for (int j = 1; j < 16; ++j) e += (pm >= tb[j]) ? 1 : 0;
        u.pm = pm; u.pn = __builtin_amdgcn_readfirstlane(e * nN + pnl); return true;
    }
};

__device__ __forceinline__ void glds16s(const void* sbase, unsigned voff, unsigned lds_dst) {
    unsigned keep;
    asm volatile("s_mov_b32 %0, m0\n\ts_mov_b32 m0, %3\n\ts_nop 0\n\tglobal_load_lds_dwordx4 %1, %2\n\ts_mov_b32 m0, %0"
                 : "=&s"(keep) : "v"(voff), "s"(sbase), "s"(lds_dst) : "memory");
}
__device__ __forceinline__ unsigned cvt_pk_bf16(float lo, float hi) { unsigned r; asm volatile("v_cvt_pk_bf16_f32 %0, %1, %2" : "=v"(r) : "v"(lo), "v"(hi)); return r; }

template <class Epi, class Sched, bool ALIGN_EPI, bool GATHER>
__device__ __forceinline__ void gemm_phase(PG8_LAS unsigned char* lds, const Gemm g, const Sched& S, const Epi& E, const int tid) {
    const int wid = __builtin_amdgcn_readfirstlane(tid >> 6), lane = tid & 63, wr = wid >> 2, wc = wid & 3, fr = lane & 15, fq = lane >> 4;
    const int K = g.K, nt = K / BK;
    int RA[2], CA[2]; unsigned voffB[2];
#pragma unroll
    for (int i = 0; i < 2; ++i) { int R, C; stage_rc(tid * 16 + i * 8192, R, C); const int Rb = Epi::PERM ? ((R & ~31) + perm32(R & 31)) : R;
        RA[i] = R; CA[i] = C; voffB[i] = (unsigned)(Rb * K + C) * 2u; }
    const size_t kstep = (size_t)(BK * 2);
    const size_t hstep = (size_t)HALF * K * 2;
    const size_t tstep = 2 * hstep;
    const unsigned ldsw = (unsigned)wid * 1024u;
    const unsigned ldsbase = (unsigned)__builtin_amdgcn_readfirstlane((int)((unsigned)(uintptr_t)lds + ldsw));
    const int aoff = lds_byte(wr * 64 + fr, fq * 8), boff = lds_byte(wc * 32 + fr, fq * 8);
#define PG8_SA(b, h) (((b) * 2 + (h)) * HTB)
#define PG8_SB(b, h) ((4 + (b) * 2 + (h)) * HTB)
#define PG8_STAGE(bufoff, gbase, voff) do { _Pragma("unroll") for (int _i = 0; _i < 2; ++_i) \
        glds16s((const char*)(gbase), (voff)[_i], ldsbase + (unsigned)((bufoff) + _i * 8192)); } while (0)
#define PG8_LDA(dst, b, h) do { _Pragma("unroll") for (int m = 0; m < 4; ++m) _Pragma("unroll") for (int k = 0; k < 2; ++k) dst[m][k] = *(const PG8_LAS bf16x8*)(lds + PG8_SA(b, h) + aoff + m * 2048 + k * 1024); } while (0)
#define PG8_LDB(dst, b, h) do { _Pragma("unroll") for (int n = 0; n < 2; ++n) _Pragma("unroll") for (int k = 0; k < 2; ++k) dst[n][k] = *(const PG8_LAS bf16x8*)(lds + PG8_SB(b, h) + boff + n * 2048 + k * 1024); } while (0)
#define PG8_MMA(ai, bj, At, Bt) do { __builtin_amdgcn_s_setprio(1); _Pragma("unroll") for (int m = 0; m < 4; ++m) _Pragma("unroll") for (int n = 0; n < 2; ++n) _Pragma("unroll") for (int k = 0; k < 2; ++k) \
        acc[ai][bj][m][n] = __builtin_amdgcn_mfma_f32_16x16x32_bf16(Bt[n][k], At[m][k], acc[ai][bj][m][n], 0, 0, 0); __builtin_amdgcn_s_setprio(0); } while (0)
#define PG8_WAIT_V(n) asm volatile("s_waitcnt vmcnt(" #n ")" ::: "memory")
#define PG8_WAIT_L(n) asm volatile("s_waitcnt lgkmcnt(" #n ")" ::: "memory")
#define PG8_BAR __builtin_amdgcn_s_barrier()
#define PG8_SCHED __builtin_amdgcn_sched_barrier(0)
#define PG8_AOFF(v, h, ord) do { _Pragma("unroll") for (int _i = 0; _i < 2; ++_i) { \
        if constexpr (GATHER) { const int _idx = g.rmc[(ord) * 256 + (h) * HALF + RA[_i]]; v[_i] = (unsigned)(_idx * K + CA[_i]) * 2u; } \
        else v[_i] = (unsigned)(((h) * HALF + RA[_i]) * K + CA[_i]) * 2u; } } while (0)
    Unit cur, nxt; int ui = 0;
    if (!S.next(0, cur)) return;
    f32x4 acc[2][2][4][2];
#pragma unroll
    for (int a = 0; a < 2; ++a)
#pragma unroll
        for (int b = 0; b < 2; ++b)
#pragma unroll
            for (int m = 0; m < 4; ++m)
#pragma unroll
                for (int n = 0; n < 2; ++n) acc[a][b][m][n] = (f32x4){0.f, 0.f, 0.f, 0.f};
    bf16x8 At[4][2], B0[2][2], B1[2][2];
    unsigned c0[2], c1[2];
    const char* cA = GATHER ? (const char*)g.A : (const char*)g.A + (size_t)cur.pm * tstep; const char* cB = (const char*)g.Bt + (size_t)cur.pn * tstep;
    PG8_AOFF(c0, 0, 0); PG8_AOFF(c1, 1, 0);
    PG8_STAGE(PG8_SB(0, 0), cB, voffB); PG8_STAGE(PG8_SB(0, 1), cB + hstep, voffB); PG8_STAGE(PG8_SA(0, 0), cA, c0); PG8_STAGE(PG8_SA(0, 1), cA, c1);
    if (wr == 1) PG8_BAR;
    PG8_WAIT_V(2); PG8_BAR;
    PG8_STAGE(PG8_SB(1, 0), cB + kstep, voffB); PG8_STAGE(PG8_SA(1, 0), cA + kstep, c0); PG8_STAGE(PG8_SB(1, 1), cB + hstep + kstep, voffB);
    PG8_WAIT_V(6); PG8_BAR;
    for (;;) {
        const bool has_next = S.next(ui + 1, nxt);
        const char* nA = GATHER ? (const char*)g.A : (has_next ? (const char*)g.A + (size_t)nxt.pm * tstep : cA);
        const char* nB = has_next ? (const char*)g.Bt + (size_t)nxt.pn * tstep : cB;
        const int nord = has_next ? ui + 1 : ui;
        for (int t = 0; t < nt; t += 2) {
            const bool last = (t == nt - 2);
            const char* a1 = cA + (size_t)(t + 1) * kstep;
            const char* a2 = last ? nA : cA + (size_t)(t + 2) * kstep; const char* b2 = last ? nB : cB + (size_t)(t + 2) * kstep;
            const char* a3 = a2 + kstep; const char* b3 = b2 + kstep;
            PG8_LDB(B0, 0, 0); PG8_LDB(B1, 0, 1); PG8_SCHED; PG8_LDA(At, 0, 0); PG8_STAGE(PG8_SA(1, 1), a1, c1);
            if constexpr (GATHER) { if (last) { PG8_AOFF(c0, 0, nord); PG8_AOFF(c1, 1, nord); } }
            PG8_WAIT_V(8); PG8_WAIT_L(0); PG8_BAR; PG8_MMA(0, 0, At, B0); PG8_MMA(0, 1, At, B1); PG8_BAR; PG8_SCHED;
            PG8_LDA(At, 0, 1); PG8_STAGE(PG8_SB(0, 0), b2, voffB); PG8_STAGE(PG8_SB(0, 1), b2 + hstep, voffB); PG8_STAGE(PG8_SA(0, 0), a2, c0);
            PG8_WAIT_V(8); PG8_WAIT_L(0); PG8_BAR; PG8_MMA(1, 0, At, B0); PG8_MMA(1, 1, At, B1); PG8_BAR; PG8_SCHED;
            PG8_LDB(B0, 1, 0); PG8_LDB(B1, 1, 1); PG8_SCHED; PG8_LDA(At, 1, 0); PG8_STAGE(PG8_SA(0, 1), a2, c1);
            PG8_WAIT_V(8); PG8_WAIT_L(0); PG8_BAR; PG8_MMA(0, 0, At, B0); PG8_MMA(0, 1, At, B1); PG8_BAR; PG8_SCHED;
            PG8_LDA(At, 1, 1); PG8_STAGE(PG8_SB(1, 0), b3, voffB); PG8_STAGE(PG8_SB(1, 1), b3 + hstep, voffB); PG8_STAGE(PG8_SA(1, 0), a3, c0);
            PG8_WAIT_V(8); PG8_WAIT_L(0); PG8_BAR; PG8_MMA(1, 0, At, B0); PG8_MMA(1, 1, At, B1); PG8_BAR; PG8_SCHED;
        }
        if constexpr (ALIGN_EPI) { if (wr == 0) PG8_BAR; }
        E(acc, cur, wr, wc, fr, fq);
        if (!has_next) break;
#pragma unroll
        for (int a = 0; a < 2; ++a)
#pragma unroll
            for (int b = 0; b < 2; ++b)
#pragma unroll
                for (int m = 0; m < 4; ++m)
#pragma unroll
                    for (int n = 0; n < 2; ++n) acc[a][b][m][n] = (f32x4){0.f, 0.f, 0.f, 0.f};
        cur = nxt; cA = nA; cB = nB; ++ui;
        if constexpr (ALIGN_EPI) { if (wr == 1) PG8_BAR; }
    }
    PG8_WAIT_V(0);
    if constexpr (!ALIGN_EPI) { if (wr == 0) PG8_BAR; }
    PG8_BAR;
#undef PG8_SA
#undef PG8_SB
#undef PG8_STAGE
#undef PG8_LDA
#undef PG8_LDB
#undef PG8_MMA
#undef PG8_WAIT_V
#undef PG8_WAIT_L
#undef PG8_BAR
#undef PG8_SCHED
#undef PG8_AOFF
}
}

#include <hip/hip_bf16.h>
#include <cmath>
namespace attn_body {
using bf16=__hip_bfloat16;
using bf16x8=__attribute__((ext_vector_type(8)))short;
using s16x4=__attribute__((ext_vector_type(4)))short;
using f32x16=__attribute__((ext_vector_type(16)))float;
using u32x4=__attribute__((ext_vector_type(4)))unsigned;
constexpr int D=64,DM=1024;
constexpr int NW=8,QBLK=32,QB=QBLK*NW,KVBLK=64;
__device__ __forceinline__ int crow(int r,int hi){return (r&3)+8*(r>>2)+4*hi;}
#define SBAR() __builtin_amdgcn_sched_barrier(0)
__device__ __forceinline__ void wmask(f32x16&p0,f32x16&p1,int d0,int hi){
  const float NEG=-INFINITY; const int kb=d0+4*hi;
  #pragma unroll
  for(int r=0;r<16;++r){const int d=kb+(r&3)+8*(r>>2); if(d>128||d<-128)p0[r]=NEG; if(d+32>128||d+32<-128)p1[r]=NEG;}
}

constexpr int NSLOT=3, SLOTB=8192;
constexpr int LDS_K=0, LDS_V=NSLOT*SLOTB, LDS_WS=2*NSLOT*SLOTB, LDS_OST=LDS_WS+NW*64*4, LDS_BYTES=LDS_OST+NW*4096;
constexpr float C2=0.125f*1.4426950408889634f;
__device__ __forceinline__ void glds16(const void*gsrc,unsigned lds_dst){unsigned keep;
  asm volatile("s_mov_b32 %0, m0\n\ts_mov_b32 m0, %2\n\ts_nop 0\n\tglobal_load_lds_dwordx4 %1, off\n\ts_mov_b32 m0, %0":"=&s"(keep):"v"(gsrc),"s"(lds_dst):"memory");}
__device__ __forceinline__ float max3f(float a,float b,float c){float r;asm("v_max3_f32 %0, %1, %2, %3":"=v"(r):"v"(a),"v"(b),"v"(c));return r;}
__device__ __forceinline__ float max2f(float a,float b){float r;asm("v_max_f32_e32 %0, %1, %2":"=v"(r):"v"(a),"v"(b));return r;}
__device__ __forceinline__ float fadd_s(float a,float b){float r;asm("v_add_f32_e32 %0, %1, %2":"=v"(r):"v"(a),"v"(b));return r;}
__device__ __forceinline__ float fsub_s(float a,float b){float r;asm("v_sub_f32_e32 %0, %1, %2":"=v"(r):"v"(a),"v"(b));return r;}
typedef float f32x2_t __attribute__((ext_vector_type(2))); typedef __bf16 bf16x2_t __attribute__((ext_vector_type(2)));
__device__ __forceinline__ unsigned cvtpk_s(float lo,float hi){f32x2_t v={lo,hi};bf16x2_t b=__builtin_convertvector(v,bf16x2_t);return __builtin_bit_cast(unsigned,b);}
#define WAIT_BAR(N) asm volatile("s_waitcnt vmcnt(" #N ") lgkmcnt(0)\n\ts_barrier":::"memory")

__device__ __forceinline__ void qkt(f32x16&p0,f32x16&p1,const char*Kslot,const bf16x8*qr,const f32x16&negm,int r32,int hi){
  const char*kb=Kslot+hi*1024+r32*16;
  #pragma unroll
  for(int d0=0;d0<4;++d0){
    const bf16x8 b0=*reinterpret_cast<const bf16x8*>(kb+d0*2048);
    const bf16x8 b1=*reinterpret_cast<const bf16x8*>(kb+d0*2048+512);
    if(d0==0){p0=__builtin_amdgcn_mfma_f32_32x32x16_bf16(b0,qr[0],negm,0,0,0);p1=__builtin_amdgcn_mfma_f32_32x32x16_bf16(b1,qr[0],negm,0,0,0);}
    else{p0=__builtin_amdgcn_mfma_f32_32x32x16_bf16(b0,qr[d0],p0,0,0,0);p1=__builtin_amdgcn_mfma_f32_32x32x16_bf16(b1,qr[d0],p1,0,0,0);}}
}
typedef __attribute__((address_space(3))) const char* lds_cptr;
typedef short v4i16_t __attribute__((ext_vector_type(4)));
__device__ __forceinline__ void kload8(bf16x8*kf,lds_cptr kp){
  kf[0]=*(const __attribute__((address_space(3))) bf16x8*)(kp);      kf[1]=*(const __attribute__((address_space(3))) bf16x8*)(kp+512);
  kf[2]=*(const __attribute__((address_space(3))) bf16x8*)(kp+2048); kf[3]=*(const __attribute__((address_space(3))) bf16x8*)(kp+2560);
  kf[4]=*(const __attribute__((address_space(3))) bf16x8*)(kp+4096); kf[5]=*(const __attribute__((address_space(3))) bf16x8*)(kp+4608);
  kf[6]=*(const __attribute__((address_space(3))) bf16x8*)(kp+6144); kf[7]=*(const __attribute__((address_space(3))) bf16x8*)(kp+6656);
}
__device__ __forceinline__ void kload2(bf16x8*kf,lds_cptr kp,int j){ kf[2*j]=*(const __attribute__((address_space(3))) bf16x8*)(kp+j*2048); kf[2*j+1]=*(const __attribute__((address_space(3))) bf16x8*)(kp+j*2048+512); }
__device__ __forceinline__ s16x4 vtr(lds_cptr p){ return __builtin_bit_cast(s16x4,__builtin_amdgcn_ds_read_tr16_b64_v4i16((__attribute__((address_space(3))) v4i16_t*)p)); }
__device__ __forceinline__ float rowmax(const f32x16&p0,const f32x16&p1){
  float a=max3f(p0[0],p0[1],p1[0]),b=max3f(p0[2],p0[3],p1[1]);a=max3f(a,p1[2],p1[3]);
  #pragma unroll
  for(int r=4;r<16;r+=4){a=max3f(a,p0[r],p0[r+1]);b=max3f(b,p0[r+2],p0[r+3]);a=max3f(a,p1[r],p1[r+1]);b=max3f(b,p1[r+2],p1[r+3]);}
  const float m=max2f(a,b);
  auto rr=__builtin_amdgcn_permlane32_swap(__float_as_uint(m),__float_as_uint(m),false,false);
  return max2f(__uint_as_float(rr[0]),__uint_as_float(rr[1]));
}
__device__ __forceinline__ void pv(f32x16*o,int vb,bf16x8 pa0,bf16x8 pa1,bf16x8 pa2,bf16x8 pa3){
  #pragma unroll
  for(int d0=0;d0<2;++d0){s16x4 lo[4],hi[4];
    #pragma unroll
    for(int ks=0;ks<4;++ks){
      asm volatile("ds_read_b64_tr_b16 %0,%1 offset:%c2":"=&v"(lo[ks]):"v"(vb),"i"(d0*4096+ks*1024):"memory");
      asm volatile("ds_read_b64_tr_b16 %0,%1 offset:%c2":"=&v"(hi[ks]):"v"(vb),"i"(d0*4096+ks*1024+512):"memory");}
    asm volatile("s_waitcnt lgkmcnt(0)":::"memory");SBAR();
    #define PK(k) (bf16x8){lo[k][0],lo[k][1],lo[k][2],lo[k][3],hi[k][0],hi[k][1],hi[k][2],hi[k][3]}
    o[d0]=__builtin_amdgcn_mfma_f32_32x32x16_bf16(pa0,PK(0),o[d0],0,0,0);
    o[d0]=__builtin_amdgcn_mfma_f32_32x32x16_bf16(pa1,PK(1),o[d0],0,0,0);
    o[d0]=__builtin_amdgcn_mfma_f32_32x32x16_bf16(pa2,PK(2),o[d0],0,0,0);
    o[d0]=__builtin_amdgcn_mfma_f32_32x32x16_bf16(pa3,PK(3),o[d0],0,0,0);
    #undef PK
  }
}

#ifndef ATTN_STORE16
#define ATTN_STORE16(p,v) (*(u32x4*)(p)=(v))
#endif
template<int THRL,int WIN> __device__ __forceinline__ void attn_unit(const bf16*Qb,const bf16*Kc,const bf16*Vc,int ctxrow,int latrow,int NT,int dq0,float sink2,char*shm,const int tid){
  const int lane=tid&63,r32=lane&31,hi=lane>>5; const int wid=__builtin_amdgcn_readfirstlane(tid>>6);
  const bf16*Qw=Qb+(long)(wid*QBLK)*DM;
  #define TROW(t) ((t)<4?ctxrow+64*(t):latrow+64*((t)-4))
  const unsigned lds0=(unsigned)(uintptr_t)shm;
  float*wsf=(float*)(shm+LDS_WS)+wid*64;
  const bf16*ksrc=Kc+(long)lane*DM+wid*8;
  const bf16*vsrc=Vc+(long)(16*(wid&3)+(lane>>2))*DM+(wid>>2)*32+(lane&3)*8;
  const unsigned kdst=lds0+LDS_K+wid*1024, vdst=lds0+LDS_V+wid*1024;
  #define DMA_K(t,slot) glds16(ksrc+(long)TROW(t)*DM,(unsigned)__builtin_amdgcn_readfirstlane(kdst+(slot)))
  #define DMA_V(t,slot) glds16(vsrc+(long)TROW(t)*DM,(unsigned)__builtin_amdgcn_readfirstlane(vdst+(slot)))
  const int vb0=(int)(lds0+LDS_V)+((lane>>4)&1)*32+(lane&3)*8+(4*hi+((lane&15)>>2))*64;
  const char*Kbase=shm+LDS_K; bf16x8 kf[8];
  const lds_cptr shm3=(lds_cptr)shm; const lds_cptr kp0=shm3+LDS_K+hi*1024+r32*16; const lds_cptr vp0=shm3+LDS_V+((lane>>4)&1)*32+(lane&3)*8+(4*hi+((lane&15)>>2))*64;
  DMA_K(0,0);DMA_V(0,0);DMA_K(1,SLOTB);
  bf16x8 qr[4];
  #pragma unroll
  for(int d0=0;d0<4;++d0)qr[d0]=*reinterpret_cast<const __attribute__((address_space(1))) bf16x8*>((const __attribute__((address_space(1))) bf16*)Qw+((long)r32*DM+d0*16+hi*8));
  float zf_; asm volatile("v_mov_b32 %0, 0":"=v"(zf_));
  float mhat=zf_,l_reg=zf_;f32x16 o[2],negm;
  #pragma unroll
  for(int r=0;r<16;++r){o[0][r]=zf_;o[1][r]=zf_;negm[r]=zf_;}
  asm volatile("":"+v"(negm));
  const int qrel=wid*QBLK+r32;
  #define CMASK(P0,P1,t) do{ if constexpr(WIN!=0){ if((t)>=4) wmask(P0,P1,dq0+64*((t)-4)-qrel,hi); } }while(0)
  bool resc=false;
  #define START(P0,P1) do{ const float rm=rowmax(P0,P1); resc=false; \
    { const float dl=rm; mhat=fadd_s(mhat,dl); \
      _Pragma("unroll") for(int r=0;r<16;++r){P0[r]=fsub_s(P0[r],dl);P1[r]=fsub_s(P1[r],dl);} \
      _Pragma("unroll") for(int r=0;r<16;++r)negm[r]=-mhat; asm volatile("":"+v"(negm)); } \
    _Pragma("unroll") for(int r=0;r<16;++r)P0[r]=__builtin_amdgcn_exp2f(P0[r]); }while(0)
  #define RESC() do{ if(resc){ asm volatile("s_waitcnt lgkmcnt(0)":::"memory"); \
      _Pragma("unroll") for(int d_=0;d_<2;++d_) _Pragma("unroll") for(int r=0;r<16;++r)o[d_][r]*=wsf[crow(r,hi)]; } }while(0)
  f32x16 pA0,pA1,pB0,pB1;
  int sl_prev=0,sl_cur=0,sl_next=SLOTB;
  #define ROT() do{sl_prev=sl_cur;sl_cur=sl_next;sl_next=(sl_next==(NSLOT-1)*SLOTB)?0:sl_next+SLOTB;}while(0)
  DMA_K(2,2*SLOTB);
  WAIT_BAR(3);
  qkt(pA0,pA1,Kbase,qr,negm,r32,hi);asm volatile("s_nop 15\n\ts_nop 7":"+v"(pA0),"+v"(pA1));CMASK(pA0,pA1,0);
  START(pA0,pA1);
  _Pragma("unroll") for(int r=0;r<16;++r)pA1[r]=__builtin_amdgcn_exp2f(pA1[r]);
  WAIT_BAR(0);
  DMA_K(3,0);DMA_V(1,SLOTB);
  ROT();
  kload8(kf,kp0+sl_cur);
  WAIT_BAR(2);
  s16x4 vlo[8],vhi[8]; u32x4 pw0,pw1,pw2,pw3;
  #define PKW(P,B) cvtpk_s(P[B],P[B+1])
  #define PAF(k) __builtin_bit_cast(bf16x8,pw##k)
  #define VFR(i) (bf16x8){vlo[i][0],vlo[i][1],vlo[i][2],vlo[i][3],vhi[i][0],vhi[i][1],vhi[i][2],vhi[i][3]}
  #define PIN(x) asm volatile("":"+v"(x))
  #define MX3(a,b,c) __builtin_fmaxf(__builtin_fmaxf((a),(b)),(c))
  #define GAPA(MF,A0,A1,A2,A3,W0,W1,PW) do{ MF; sacc+=A0; sacc+=A1; sacc+=A2; sacc+=A3; PIN(sacc); W0; W1; PIN(PW); SBAR(); }while(0)
  #define EX(v) __builtin_amdgcn_exp2f(v)
  #define GAPB(MF,X,B) do{ MF; X[B]=EX(X[B]); X[B+1]=EX(X[B+1]); X[B+2]=EX(X[B+2]); X[B+3]=EX(X[B+3]); PIN(X); SBAR(); }while(0)
  #define VRD(i) do{ vlo[i]=vtr(vp_+(((i)>>2)*4096+((i)&3)*1024)); vhi[i]=vtr(vp_+(((i)>>2)*4096+((i)&3)*1024+512)); }while(0)
  #define KRD(G,j) do{ if(G){ kload2(kf,kp0+sl_next,j); SBAR(); } }while(0)
  #define STEP(C0,C1,P0,P1,t,GK,GV,GL) do{ SBAR(); \
    const lds_cptr vp_=vp0+sl_prev; \
    VRD(0); SBAR(); float sacc=(P0[0]+P0[1]); \
    GAPA(C0=__builtin_amdgcn_mfma_f32_32x32x16_bf16(kf[0],qr[0],negm,0,0,0), P0[2],P0[3],P0[4],P0[5],     pw0[0]=PKW(P0,0), pw0[1]=PKW(P0,2), pw0); \
    VRD(4); SBAR(); GAPA(C1=__builtin_amdgcn_mfma_f32_32x32x16_bf16(kf[1],qr[0],negm,0,0,0), P0[6],P0[7],P0[8],P0[9],     pw0[2]=PKW(P0,4), pw0[3]=PKW(P0,6), pw0); \
    VRD(1); SBAR(); GAPA(C0=__builtin_amdgcn_mfma_f32_32x32x16_bf16(kf[2],qr[1],C0,0,0,0),   P0[10],P0[11],P0[12],P0[13], pw1[0]=PKW(P0,8), pw1[1]=PKW(P0,10), pw1); \
    VRD(5); SBAR(); GAPA(C1=__builtin_amdgcn_mfma_f32_32x32x16_bf16(kf[3],qr[1],C1,0,0,0),   P0[14],P0[15],P1[0],P1[1],   pw1[2]=PKW(P0,12),pw1[3]=PKW(P0,14), pw1); \
    VRD(2); SBAR(); GAPA(C0=__builtin_amdgcn_mfma_f32_32x32x16_bf16(kf[4],qr[2],C0,0,0,0),   P1[2],P1[3],P1[4],P1[5],     pw2[0]=PKW(P1,0), pw2[1]=PKW(P1,2), pw2); \
    VRD(6); SBAR(); GAPA(C1=__builtin_amdgcn_mfma_f32_32x32x16_bf16(kf[5],qr[2],C1,0,0,0),   P1[6],P1[7],P1[8],P1[9],     pw2[2]=PKW(P1,4), pw2[3]=PKW(P1,6), pw2); \
    VRD(3); SBAR(); GAPA(C0=__builtin_amdgcn_mfma_f32_32x32x16_bf16(kf[6],qr[3],C0,0,0,0),   P1[10],P1[11],P1[12],P1[13], pw3[0]=PKW(P1,8), pw3[1]=PKW(P1,10), pw3); \
    VRD(7); SBAR(); GAPA(C1=__builtin_amdgcn_mfma_f32_32x32x16_bf16(kf[7],qr[3],C1,0,0,0),   P1[14],P1[15],0.f,0.f,       pw3[2]=PKW(P1,12),pw3[3]=PKW(P1,14), pw3); \
    l_reg+=sacc; \
    if(GK){DMA_K((t)+3,sl_cur);} if(GV){DMA_V((t)+1,sl_next);} \
    CMASK(C0,C1,t); \
    { float a=MX3(C0[0],C0[1],C1[0]),b=MX3(C0[2],C0[3],C1[1]); a=MX3(a,C1[2],C1[3]); \
      _Pragma("unroll") for(int r=4;r<16;r+=4){a=MX3(a,C0[r],C0[r+1]);b=MX3(b,C0[r+2],C0[r+3]);a=MX3(a,C1[r],C1[r+1]);b=MX3(b,C1[r+2],C1[r+3]);} \
      float rm=__builtin_fmaxf(a,b); { auto rr=__builtin_amdgcn_permlane32_swap(__float_as_uint(rm),__float_as_uint(rm),false,false); rm=__builtin_fmaxf(__uint_as_float(rr[0]),__uint_as_float(rr[1])); } \
      resc=false; \
      if(__builtin_expect(__any(rm>(float)THRL),0)){ const float dl=__builtin_fmaxf(rm,0.f); mhat+=dl; \
        _Pragma("unroll") for(int r=0;r<16;++r){C0[r]-=dl;C1[r]-=dl;} \
        _Pragma("unroll") for(int r=0;r<16;++r)negm[r]=-mhat; asm volatile("":"+v"(negm)); \
        const float f=__builtin_amdgcn_exp2f(-dl); l_reg*=f; if(hi==0)wsf[r32]=f; resc=true; } } \
    SBAR(); \
    GAPB(o[0]=__builtin_amdgcn_mfma_f32_32x32x16_bf16(PAF(0),VFR(0),o[0],0,0,0), C0,0); \
    GAPB(o[1]=__builtin_amdgcn_mfma_f32_32x32x16_bf16(PAF(0),VFR(4),o[1],0,0,0), C0,4); \
    KRD(GL,0); GAPB(o[0]=__builtin_amdgcn_mfma_f32_32x32x16_bf16(PAF(1),VFR(1),o[0],0,0,0), C0,8); \
    KRD(GL,1); GAPB(o[1]=__builtin_amdgcn_mfma_f32_32x32x16_bf16(PAF(1),VFR(5),o[1],0,0,0), C0,12); \
    KRD(GL,2); GAPB(o[0]=__builtin_amdgcn_mfma_f32_32x32x16_bf16(PAF(2),VFR(2),o[0],0,0,0), C1,0); \
    KRD(GL,3); GAPB(o[1]=__builtin_amdgcn_mfma_f32_32x32x16_bf16(PAF(2),VFR(6),o[1],0,0,0), C1,4); \
    GAPB(o[0]=__builtin_amdgcn_mfma_f32_32x32x16_bf16(PAF(3),VFR(3),o[0],0,0,0), C1,8); \
    GAPB(o[1]=__builtin_amdgcn_mfma_f32_32x32x16_bf16(PAF(3),VFR(7),o[1],0,0,0), C1,12); \
    }while(0)
  int t=1;
  for(;t+5<NT;t+=2){
    STEP(pB0,pB1,pA0,pA1,t,true,true,true);     WAIT_BAR(2); RESC(); ROT();
    STEP(pA0,pA1,pB0,pB1,t+1,true,true,true);   WAIT_BAR(2); RESC(); ROT();
  }
  #define ENDW(tt) do{ if((tt)+3<NT){WAIT_BAR(2);} else if((tt)+2<NT){WAIT_BAR(1);} else {WAIT_BAR(0);} }while(0)
  for(;t+1<NT;t+=2){
    STEP(pB0,pB1,pA0,pA1,t,(t+3<NT),(t+1<NT),(t+1<NT));       ENDW(t);   RESC(); ROT();
    STEP(pA0,pA1,pB0,pB1,t+1,(t+4<NT),(t+2<NT),(t+2<NT));     ENDW(t+1); RESC(); ROT();
  }
  STEP(pB0,pB1,pA0,pA1,NT-1,false,false,false); RESC();
  { float sacc=pB0[0]+pB0[1]; _Pragma("unroll") for(int r=2;r<16;++r)sacc+=pB0[r]; _Pragma("unroll") for(int r=0;r<16;++r)sacc+=pB1[r]; l_reg+=sacc;
    pw0=(u32x4){PKW(pB0,0),PKW(pB0,2),PKW(pB0,4),PKW(pB0,6)};pw1=(u32x4){PKW(pB0,8),PKW(pB0,10),PKW(pB0,12),PKW(pB0,14)};pw2=(u32x4){PKW(pB1,0),PKW(pB1,2),PKW(pB1,4),PKW(pB1,6)};pw3=(u32x4){PKW(pB1,8),PKW(pB1,10),PKW(pB1,12),PKW(pB1,14)};
    SBAR(); pv(o,vb0+sl_cur,PAF(0),PAF(1),PAF(2),PAF(3)); }
  #undef PKW
  #undef PAF
  #undef VFR
  #undef PIN
  #undef MX3
  #undef GAPA
  #undef GAPB
  #undef EX
  #undef VRD
  #undef KRD
  #undef STEP
  #undef ENDW
  {auto rr=__builtin_amdgcn_permlane32_swap(__float_as_uint(l_reg),__float_as_uint(l_reg),false,false);l_reg=__uint_as_float(rr[0])+__uint_as_float(rr[1]);}
  l_reg+=__builtin_amdgcn_exp2f(sink2-mhat);
  if(hi==0)wsf[32+r32]=l_reg;asm volatile("s_waitcnt lgkmcnt(0)":::"memory");
  float rli[16];
  #pragma unroll
  for(int r=0;r<16;++r)rli[r]=__builtin_amdgcn_rcpf(wsf[32+crow(r,hi)]);
  bf16*Ow=const_cast<bf16*>(Qw);
  { bf16*stg=(bf16*)(shm+LDS_OST)+wid*2048;
    #pragma unroll
    for(int r=0;r<16;++r){const int orow=crow(r,hi);
      #pragma unroll
      for(int d0=0;d0<2;++d0)stg[orow*64+d0*32+r32]=__float2bfloat16(o[d0][r]*rli[r]);}
    asm volatile("s_waitcnt lgkmcnt(0)":::"memory");
    #pragma unroll
    for(int i=0;i<4;++i){const int row=i*8+(lane>>3),ch=lane&7; const u32x4 v=*(const u32x4*)(stg+row*64+ch*8); ATTN_STORE16(Ow+(long)row*DM+ch*8,v);} }
  asm volatile("s_waitcnt lgkmcnt(0)\n\ts_barrier":::"memory");
  #undef DMA_K
  #undef DMA_V
  #undef CMASK
  #undef START
  #undef RESC
  #undef ROT
  #undef TROW
}
constexpr int ATTN_LDS_BYTES=LDS_BYTES;
#undef SBAR
#undef WAIT_BAR
}

namespace rs {
typedef short bf16x8 __attribute__((ext_vector_type(8)));
typedef float f32x16 __attribute__((ext_vector_type(16)));
typedef unsigned u32x4 __attribute__((ext_vector_type(4)));
#define RS_LAS __attribute__((address_space(3)))
#define RS_GAS __attribute__((address_space(1)))
constexpr int CH = 32, NCHUNK = 136, TILE_LD = 72, TILE_BYTES = CH * TILE_LD * 2;
__device__ __forceinline__ int crow(int r, int hi) { return (r & 3) + 8 * (r >> 2) + 4 * hi; }
typedef float f32x2_t __attribute__((ext_vector_type(2))); typedef __bf16 bf16x2_t __attribute__((ext_vector_type(2)));
__device__ __forceinline__ unsigned pk(float lo, float hi) { f32x2_t v = {lo, hi}; bf16x2_t b = __builtin_convertvector(v, bf16x2_t); return __builtin_bit_cast(unsigned, b); }
__device__ __forceinline__ bf16x8 packq(const f32x16& a, int q) { u32x4 w; w.x = pk(a[8 * q], a[8 * q + 1]); w.y = pk(a[8 * q + 2], a[8 * q + 3]); w.z = pk(a[8 * q + 4], a[8 * q + 5]); w.w = pk(a[8 * q + 6], a[8 * q + 7]); return __builtin_bit_cast(bf16x8, w); }
__device__ __forceinline__ f32x16 mf(bf16x8 a, bf16x8 b, f32x16 c) { return __builtin_amdgcn_mfma_f32_32x32x16_bf16(a, b, c, 0, 0, 0); }
__device__ __forceinline__ f32x16 zero16(float z) { f32x16 o;
#pragma unroll
    for (int r = 0; r < 16; ++r) o[r] = z; return o; }
__device__ __forceinline__ float bfl(unsigned w) { return __builtin_bit_cast(float, w << 16); }
__device__ __forceinline__ float bfh(unsigned w) { return __builtin_bit_cast(float, w & 0xffff0000u); }
__device__ __forceinline__ f32x16 unpack16(bf16x8 lo, bf16x8 hi) { const u32x4 a = __builtin_bit_cast(u32x4, lo), b = __builtin_bit_cast(u32x4, hi); f32x16 o;
    o[0] = bfl(a.x); o[1] = bfh(a.x); o[2] = bfl(a.y); o[3] = bfh(a.y); o[4] = bfl(a.z); o[5] = bfh(a.z); o[6] = bfl(a.w); o[7] = bfh(a.w);
    o[8] = bfl(b.x); o[9] = bfh(b.x); o[10] = bfl(b.y); o[11] = bfh(b.y); o[12] = bfl(b.z); o[13] = bfh(b.z); o[14] = bfl(b.w); o[15] = bfh(b.w); return o; }
template <class F> __device__ __forceinline__ void cm_frags(F m, bf16x8 (&f)[2][2]) {
#pragma unroll
    for (int q = 0; q < 2; ++q) { u32x4 a, b;
#pragma unroll
        for (int w = 0; w < 4; ++w) { const int t0 = 16 * q + ((2 * w) & 3) + 8 * ((2 * w) >> 2);
            const unsigned p0 = pk(m(t0), m(t0 + 1)), p1 = pk(m(t0 + 4), m(t0 + 5));
            auto rr = __builtin_amdgcn_permlane32_swap(p0, p1, false, false); a[w] = rr[0]; b[w] = rr[1]; }
        f[0][q] = __builtin_bit_cast(bf16x8, a); f[1][q] = __builtin_bit_cast(bf16x8, b); }
}
template <class F> __device__ __forceinline__ void tm_write(F m, RS_LAS unsigned char* tile, int lane) {
    asm volatile("s_waitcnt lgkmcnt(0)" ::: "memory");
#pragma unroll
    for (int t = 0; t < 32; t += 2) { const unsigned p = pk(m(t), m(t + 1));
        *(RS_LAS unsigned short*)(tile + (t * TILE_LD + lane) * 2) = (unsigned short)(p & 0xffffu); *(RS_LAS unsigned short*)(tile + ((t + 1) * TILE_LD + lane) * 2) = (unsigned short)(p >> 16); }
    asm volatile("s_waitcnt lgkmcnt(0)" ::: "memory");
}
__device__ __forceinline__ void tm_read(RS_LAS unsigned char* tile, int lane, bf16x8 (&f)[4]) {
    const int t = lane & 31, kg = lane >> 5;
#pragma unroll
    for (int q = 0; q < 4; ++q) f[q] = *(const RS_LAS bf16x8*)(tile + (t * TILE_LD + 16 * q + 8 * kg) * 2);
    asm volatile("s_waitcnt lgkmcnt(0)" ::: "memory");
}
__device__ __forceinline__ void tm_read_acc(RS_LAS unsigned char* tile, int lane, bf16x8 (&f)[2][2]) {
    const int t = lane & 31, kg = lane >> 5;
    typedef unsigned u32x2 __attribute__((ext_vector_type(2)));
#pragma unroll
    for (int tau = 0; tau < 2; ++tau)
#pragma unroll
        for (int q = 0; q < 2; ++q) { const u32x2 lo = *(const RS_LAS u32x2*)(tile + (t * TILE_LD + 32 * tau + 16 * q + 4 * kg) * 2), hi2 = *(const RS_LAS u32x2*)(tile + (t * TILE_LD + 32 * tau + 16 * q + 4 * kg + 8) * 2);
            u32x4 w; w.x = lo.x; w.y = lo.y; w.z = hi2.x; w.w = hi2.y; f[tau][q] = __builtin_bit_cast(bf16x8, w); }
    asm volatile("s_waitcnt lgkmcnt(0)" ::: "memory");
}
struct ChunkIn { const unsigned short* p; long rstride; const unsigned short* xl; };
struct LoraIn { const RS_LAS unsigned char* w2; const RS_LAS unsigned char* a2; const float* w0; const float* a0; unsigned short* aout; };
__device__ __forceinline__ void load_col(const ChunkIn& ci, int off, int lane, float (&m)[32]) {
    const unsigned l2 = (unsigned)lane * 2u;
#pragma unroll
    for (int t = 0; t < 32; ++t) m[t] = __builtin_bit_cast(float, (unsigned)(*(const RS_GAS unsigned short*)((const RS_GAS char*)(ci.p + ((long)t * ci.rstride + off)) + l2)) << 16);
    asm volatile("" ::: "memory");
}
template <int MODE> struct ChunkLocal {
    bf16x8 KtC[2][2], VC[2][2], BtC[2][2], KkC[2][2];
    bf16x8 RtA[2][2];
    bf16x8 pQ[2], pMbT[2], pEtT[2], pFtT[2];
    float gamma;
};
#define RS_FENCE() do { asm volatile("" ::: "memory"); __builtin_amdgcn_sched_barrier(0); } while (0)
template <int MODE> __device__ __forceinline__ void chunk_local(ChunkLocal<MODE>& o, const ChunkIn& ci, const LoraIn& lo, int dir, float ka, RS_LAS unsigned char* tile, int lane, float zf) {
    const int hi = lane >> 5, l31 = lane & 31;
    float ec[32], a[32];
    {
        bf16x8 xw[4], xa[4];
#pragma unroll
        for (int q = 0; q < 4; ++q) { const RS_GAS unsigned short* xp = (const RS_GAS unsigned short*)ci.xl + ((long)l31 * ci.rstride + dir * 64 + 16 * q + 8 * hi);
            xw[q] = *(const RS_GAS bf16x8*)xp; xa[q] = *(const RS_GAS bf16x8*)(xp + 128); }
        f32x16 aw[2], aa[2];
#pragma unroll
        for (int tau = 0; tau < 2; ++tau) { aw[tau] = zero16(zf); aa[tau] = zero16(zf);
#pragma unroll
            for (int q = 0; q < 4; ++q) { aw[tau] = mf(xw[q], *(const RS_LAS bf16x8*)(lo.w2 + ((32 * tau + l31) * 72 + 16 * q + 8 * hi) * 2), aw[tau]);
                aa[tau] = mf(xa[q], *(const RS_LAS bf16x8*)(lo.a2 + ((32 * tau + l31) * 72 + 16 * q + 8 * hi) * 2), aa[tau]); } }
        const float w0a = ((const RS_GAS float*)lo.w0)[l31], w0b = ((const RS_GAS float*)lo.w0)[32 + l31], a0a = ((const RS_GAS float*)lo.a0)[l31], a0b = ((const RS_GAS float*)lo.a0)[32 + l31];
        float lwc[32];
#pragma unroll
        for (int r = 0; r < 16; ++r) {
            const float l0 = -0.6065306597126334f * __builtin_amdgcn_rcpf(1.f + __expf(-(w0a + aw[0][r]))), l1 = -0.6065306597126334f * __builtin_amdgcn_rcpf(1.f + __expf(-(w0b + aw[1][r])));
            const float v0 = __builtin_amdgcn_rcpf(1.f + __expf(-(a0a + aa[0][r]))), v1 = __builtin_amdgcn_rcpf(1.f + __expf(-(a0b + aa[1][r])));
            auto rl = __builtin_amdgcn_permlane32_swap(__builtin_bit_cast(unsigned, l0), __builtin_bit_cast(unsigned, l1), false, false);
            auto rv = __builtin_amdgcn_permlane32_swap(__builtin_bit_cast(unsigned, v0), __builtin_bit_cast(unsigned, v1), false, false);
            unsigned rl0 = rl[0], rl1 = rl[1], rv0 = rv[0], rv1 = rv[1]; asm volatile("" : "+v"(rl0), "+v"(rl1), "+v"(rv0), "+v"(rv1));
            lwc[crow(r, 0)] = __builtin_bit_cast(float, rl0); lwc[crow(r, 1)] = __builtin_bit_cast(float, rl1);
            a[crow(r, 0)] = __builtin_bit_cast(float, rv0); a[crow(r, 1)] = __builtin_bit_cast(float, rv1); }
        float c = zf;
#pragma unroll
        for (int t = 0; t < 32; ++t) { c += lwc[t]; ec[t] = __expf(c); }
#pragma unroll
        for (int t = 0; t < 32; t += 2) { const unsigned p = pk(a[t], a[t + 1]);
            ((RS_GAS unsigned short*)lo.aout)[(long)t * ci.rstride + lane] = (unsigned short)(p & 0xffffu); ((RS_GAS unsigned short*)lo.aout)[(long)(t + 1) * ci.rstride + lane] = (unsigned short)(p >> 16); }
    }
    o.gamma = ec[31];
    RS_FENCE();
    bf16x8 KtT[4], BtT[4], KkT[4], pL[2], pLT[2];
    f32x16 aQ;
    float x[32];
    load_col(ci, 1536, lane, x);
    { auto kt = [&](int t) { return x[t] * (t == 0 ? 1.f : ec[t == 0 ? 0 : t - 1]); };
      cm_frags(kt, o.KtC); tm_write(kt, tile, lane); tm_read(tile, lane, KtT); }
    RS_FENCE();
    { auto bt = [&](int t) { return x[t] * a[t] * __builtin_amdgcn_rcpf(ec[t]); };
      if (MODE != 1) cm_frags(bt, o.BtC);
      tm_write(bt, tile, lane); tm_read(tile, lane, BtT); }
    RS_FENCE();
    { f32x16 aL = zero16(zf), aLT = zero16(zf);
#pragma unroll
      for (int q = 0; q < 4; ++q) { aL = mf(KtT[q], BtT[q], aL); aLT = mf(BtT[q], KtT[q], aLT); }
#pragma unroll
      for (int r = 0; r < 16; ++r) { const int row = crow(r, hi); aL[r] = (l31 < row) ? aL[r] : 0.f; aLT[r] = (row < l31) ? aLT[r] : 0.f; }
      pL[0] = packq(aL, 0); pL[1] = packq(aL, 1); pLT[0] = packq(aLT, 0); pLT[1] = packq(aLT, 1); }
    RS_FENCE();
    load_col(ci, 512, lane, x);
    { auto kkf = [&](int t) { return x[t] * (1.f + (a[t] - 1.f) * ka) * __builtin_amdgcn_rcpf(ec[t]); };
      if (MODE != 1) cm_frags(kkf, o.KkC);
      tm_write(kkf, tile, lane); tm_read(tile, lane, KkT); }
    RS_FENCE();
    { f32x16 aMbT = zero16(zf);
#pragma unroll
      for (int q = 0; q < 4; ++q) aMbT = mf(KkT[q], KtT[q], aMbT);
#pragma unroll
      for (int r = 0; r < 16; ++r) aMbT[r] = (crow(r, hi) < l31) ? aMbT[r] : 0.f;
      o.pMbT[0] = packq(aMbT, 0); o.pMbT[1] = packq(aMbT, 1); }
    RS_FENCE();
    if (MODE != 0) {
        bf16x8 RtT[4];
        load_col(ci, 0, lane, x);
        { auto rt = [&](int t) { return x[t] * ec[t]; };
          tm_write(rt, tile, lane); tm_read(tile, lane, RtT); }
        { f32x16 aE = zero16(zf), aF = zero16(zf);
#pragma unroll
          for (int q = 0; q < 4; ++q) { aE = mf(BtT[q], RtT[q], aE); aF = mf(KkT[q], RtT[q], aF); }
#pragma unroll
          for (int r = 0; r < 16; ++r) { const bool keep = crow(r, hi) <= l31; aE[r] = keep ? aE[r] : 0.f; aF[r] = keep ? aF[r] : 0.f; }
          o.pEtT[0] = packq(aE, 0); o.pEtT[1] = packq(aE, 1); o.pFtT[0] = packq(aF, 0); o.pFtT[1] = packq(aF, 1); }
        RS_FENCE();
        tm_read_acc(tile, lane, o.RtA);
        RS_FENCE();
    }
    load_col(ci, 1024, lane, x);
    { auto vf = [&](int t) { return x[t]; }; cm_frags(vf, o.VC); }
    RS_FENCE();
    aQ = unpack16(pLT[0], pLT[1]);
#pragma unroll
    for (int r = 0; r < 16; ++r) aQ[r] = ((crow(r, hi) == l31) ? 1.f : 0.f) - aQ[r];
#pragma unroll
    for (int lev = 0; lev < 4; ++lev) {
        f32x16 nP = mf(pLT[0], pL[0], zero16(zf)); nP = mf(pLT[1], pL[1], nP);
        if (lev < 3) { f32x16 nPT = mf(pL[0], pLT[0], zero16(zf)); nPT = mf(pL[1], pLT[1], nPT); pLT[0] = packq(nPT, 0); pLT[1] = packq(nPT, 1); }
        pL[0] = packq(nP, 0); pL[1] = packq(nP, 1);
        const bf16x8 q0 = packq(aQ, 0), q1 = packq(aQ, 1);
        aQ = mf(pL[0], q0, aQ); aQ = mf(pL[1], q1, aQ);
    }
    o.pQ[0] = packq(aQ, 0); o.pQ[1] = packq(aQ, 1);
}
template <int MODE> __device__ __forceinline__ f32x16 chunk_z(const ChunkLocal<MODE>& o, int tv, float zf) {
    f32x16 aW = mf(o.pMbT[0], o.VC[tv][0], zero16(zf)); aW = mf(o.pMbT[1], o.VC[tv][1], aW);
    const bf16x8 w0 = packq(aW, 0), w1 = packq(aW, 1);
    f32x16 aZ = mf(o.pQ[0], w0, zero16(zf)); aZ = mf(o.pQ[1], w1, aZ);
    return aZ;
}
__device__ __forceinline__ void store_frag(unsigned char* base, int idx, int lane, bf16x8 v) { *(RS_GAS u32x4*)(base + (size_t)idx * 1024 + lane * 16) = __builtin_bit_cast(u32x4, v); }
__device__ __forceinline__ bf16x8 load_frag(const unsigned char* base, int idx, int lane) { return __builtin_bit_cast(bf16x8, *(const RS_GAS u32x4*)(base + (size_t)idx * 1024 + lane * 16)); }
__device__ __forceinline__ void passA_chunk(const ChunkIn& ci, const LoraIn& lo, int dir, float ka, RS_LAS unsigned char* tile, RS_LAS float* gam, unsigned char* dump, unsigned char* dump2, int lane, float zf) {
    const int hi = lane >> 5, l31 = lane & 31;
    ChunkLocal<2> o; chunk_local<2>(o, ci, lo, dir, ka, tile, lane, zf);
    asm volatile("s_waitcnt lgkmcnt(0)" ::: "memory"); gam[lane] = o.gamma; asm volatile("s_waitcnt lgkmcnt(0)" ::: "memory");
    bf16x8 pX[2][2], pZ[2][2];
#pragma unroll
    for (int tv = 0; tv < 2; ++tv) {
        f32x16 aX = mf(o.pQ[0], o.KtC[tv][0], zero16(zf)); aX = mf(o.pQ[1], o.KtC[tv][1], aX); pX[tv][0] = packq(aX, 0); pX[tv][1] = packq(aX, 1);
        const f32x16 aZ = chunk_z<2>(o, tv, zf); pZ[tv][0] = packq(aZ, 0); pZ[tv][1] = packq(aZ, 1); }
#pragma unroll
    for (int tj = 0; tj < 2; ++tj) {
        f32x16 t2 = mf(pX[tj][0], o.pEtT[0], zero16(zf)); t2 = mf(pX[tj][1], o.pEtT[1], t2);
        f32x16 a = unpack16(o.RtA[tj][0], o.RtA[tj][1]);
#pragma unroll
        for (int r = 0; r < 16; ++r) a[r] -= t2[r];
        store_frag(dump2, tj * 2 + 0, lane, packq(a, 0)); store_frag(dump2, tj * 2 + 1, lane, packq(a, 1)); }
#pragma unroll
    for (int tv = 0; tv < 2; ++tv) {
        f32x16 a1 = mf(o.pFtT[0], o.VC[tv][0], zero16(zf)); a1 = mf(o.pFtT[1], o.VC[tv][1], a1);
        f32x16 a2 = mf(o.pEtT[0], pZ[tv][0], zero16(zf)); a2 = mf(o.pEtT[1], pZ[tv][1], a2);
#pragma unroll
        for (int r = 0; r < 16; ++r) a1[r] -= a2[r];
        store_frag(dump2, 4 + tv * 2 + 0, lane, packq(a1, 0)); store_frag(dump2, 4 + tv * 2 + 1, lane, packq(a1, 1)); }
#pragma unroll
    for (int t2 = 0; t2 < 2; ++t2)
#pragma unroll
        for (int t1 = 0; t1 < 2; ++t1) { f32x16 a = mf(pX[t2][0], o.BtC[t1][0], zero16(zf)); a = mf(pX[t2][1], o.BtC[t1][1], a);
            const float g = gam[32 * t1 + l31];
#pragma unroll
            for (int r = 0; r < 16; ++r) a[r] = g * (((t2 == t1 && crow(r, hi) == l31) ? 1.f : 0.f) - a[r]);
            store_frag(dump, (t2 * 2 + t1) * 2 + 0, lane, packq(a, 0)); store_frag(dump, (t2 * 2 + t1) * 2 + 1, lane, packq(a, 1)); }
#pragma unroll
    for (int tj = 0; tj < 2; ++tj)
#pragma unroll
        for (int tv = 0; tv < 2; ++tv) { f32x16 a1 = mf(o.KkC[tj][0], o.VC[tv][0], zero16(zf)); a1 = mf(o.KkC[tj][1], o.VC[tv][1], a1);
            f32x16 a2 = mf(o.BtC[tj][0], pZ[tv][0], zero16(zf)); a2 = mf(o.BtC[tj][1], pZ[tv][1], a2);
#pragma unroll
            for (int r = 0; r < 16; ++r) a1[r] = gam[32 * tj + crow(r, hi)] * (a1[r] - a2[r]);
            store_frag(dump, 8 + (tj * 2 + tv) * 2 + 0, lane, packq(a1, 0)); store_frag(dump, 8 + (tj * 2 + tv) * 2 + 1, lane, packq(a1, 1)); }
}
__device__ __forceinline__ void state_step(const unsigned char* dump, int lane, const bf16x8 (&pS)[4][2], f32x16 (&aS)[4]) {
    bf16x8 M[8], G[8];
#pragma unroll
    for (int i = 0; i < 8; ++i) { M[i] = load_frag(dump, i, lane); G[i] = load_frag(dump, 8 + i, lane); }
#pragma unroll
    for (int tj = 0; tj < 2; ++tj)
#pragma unroll
        for (int tv = 0; tv < 2; ++tv) { f32x16 a = unpack16(G[(tj * 2 + tv) * 2], G[(tj * 2 + tv) * 2 + 1]);
#pragma unroll
            for (int tp = 0; tp < 2; ++tp)
#pragma unroll
                for (int q = 0; q < 2; ++q) a = mf(M[(tp * 2 + tj) * 2 + q], pS[tp * 2 + tv][q], a);
            aS[tj * 2 + tv] = a; }
}
#undef RS_FENCE
#undef RS_LAS
#undef RS_GAS
}

constexpr int NWAVES = 8;
constexpr int NB = 8, SEQ = 4096, D = 1024, NCTX = 256, DEPTH = 2;
constexpr int TL = NB * SEQ, TC = NB * NCTX, T = TL + TC;
constexpr int INC = 2944, INP = 3072, RW = 512, RC = 1920, URP = 2112, SCP = 4160;
constexpr int NEXP = 16, MAXSLOT = 73728;
constexpr float C2 = 0.125f * 1.4426950408889634f;
constexpr float LOG2E = 1.4426950408889634f;

constexpr size_t MiB = 1u << 20;
constexpr size_t WS_CTL = 0, CTL_ZERO_BYTES = 1 * MiB;
constexpr size_t WS_MODS = 1 * MiB;
constexpr size_t WS_ROPE = 2 * MiB;
constexpr size_t WS_TOK = 3 * MiB;
constexpr size_t WS_RMAP = 4 * MiB;
constexpr size_t WS_WIN = 5 * MiB;
constexpr size_t WS_WOUT = 17 * MiB;
constexpr size_t WS_XN = 21 * MiB;
constexpr size_t WS_QKV = 89 * MiB;
constexpr size_t WS_UR = 157 * MiB;
constexpr size_t WS_Y = WS_QKV;
constexpr size_t WS_BIG = 298 * MiB;
constexpr size_t WS_WGU = WS_BIG, WS_WDN = WS_BIG + 64 * MiB, WS_HMID = WS_BIG + 96 * MiB;
constexpr size_t WS_HC = 575 * MiB;
constexpr size_t WS_SGD = 583 * MiB;
constexpr size_t WS_LORA = 592 * MiB;
constexpr size_t WS_END = 593 * MiB;
static_assert(WS_UR + (size_t)T * URP * 2 <= WS_BIG && WS_BIG + (size_t)T * SCP * 2 <= WS_HC && WS_QKV + (size_t)MAXSLOT * D * 2 <= WS_BIG && WS_HMID + (size_t)MAXSLOT * D * 2 <= WS_HC, "d_ws map");
constexpr size_t WS_SCD = WS_UR;
constexpr size_t WS_STF = WS_XN;
constexpr int CW_CNT = 64;
constexpr int CW_CUR = 128;
constexpr int CW_BAR = 4096;

constexpr int RING_BYTES = 131072;
constexpr int RMC_OFF = RING_BYTES, RMC_BYTES = 12288;
constexpr int LDSCTL_OFF = RMC_OFF + RMC_BYTES;
constexpr int LDS_BYTES = 147456;

#define GAS __attribute__((address_space(1)))
#define LAS __attribute__((address_space(3)))
typedef unsigned short bf16;
typedef unsigned v4u __attribute__((ext_vector_type(4)));
typedef unsigned v2u __attribute__((ext_vector_type(2)));
typedef float f32x4 __attribute__((ext_vector_type(4)));
#define LDS_WAIT() asm volatile("s_waitcnt lgkmcnt(0)" ::: "memory")
#define VM_WAIT() asm volatile("s_waitcnt vmcnt(0)" ::: "memory")
__device__ __forceinline__ unsigned f2bf(float f) { unsigned u = __builtin_bit_cast(unsigned, f); return (u + 0x7fffu + ((u >> 16) & 1u)) >> 16; }
__device__ __forceinline__ unsigned pk2(float lo, float hi) { return f2bf(lo) | (f2bf(hi) << 16); }
__device__ __forceinline__ float bf2f(unsigned short b) { return __builtin_bit_cast(float, (unsigned)b << 16); }
__device__ __forceinline__ float bflo(unsigned w) { return __builtin_bit_cast(float, w << 16); }
__device__ __forceinline__ float bfhi(unsigned w) { return __builtin_bit_cast(float, w & 0xffff0000u); }
#define DPP_ADD(v, ctrl) ((v) + __builtin_bit_cast(float, __builtin_amdgcn_update_dpp(0, __builtin_bit_cast(int, (v)), (ctrl), 0xf, 0xf, true)))
__device__ __forceinline__ float quad_sum(float v) { v = DPP_ADD(v, 0xB1); v = DPP_ADD(v, 0x4E); return v; }
__device__ __forceinline__ float row_sum(float v) { v = DPP_ADD(v, 0xB1); v = DPP_ADD(v, 0x4E); v = DPP_ADD(v, 0x141); v = DPP_ADD(v, 0x140); return v; }
__device__ __forceinline__ float wave_sum(float v) {
    v = DPP_ADD(v, 0xB1); v = DPP_ADD(v, 0x4E); v = DPP_ADD(v, 0x141); v = DPP_ADD(v, 0x140);
    const int b = __builtin_bit_cast(int, v);
    const float s0 = __builtin_bit_cast(float, __builtin_amdgcn_readlane(b, 0)), s1 = __builtin_bit_cast(float, __builtin_amdgcn_readlane(b, 16)),
                s2 = __builtin_bit_cast(float, __builtin_amdgcn_readlane(b, 32)), s3 = __builtin_bit_cast(float, __builtin_amdgcn_readlane(b, 48));
    return (s0 + s1) + (s2 + s3);
}
__device__ __forceinline__ float half_sum2(float s) { unsigned a = __builtin_bit_cast(unsigned, s), b; asm volatile("v_mov_b32 %0, %1" : "=v"(b) : "v"(a));
    auto rr = __builtin_amdgcn_permlane32_swap(a, b, false, false); unsigned r0 = rr[0], r1 = rr[1]; asm volatile("" : "+v"(r0), "+v"(r1));
    return __builtin_bit_cast(float, r0) + __builtin_bit_cast(float, r1); }
__device__ __forceinline__ int fresh_lane() { int z; asm volatile("s_mov_b32 %0, 0" : "=s"(z)); return (int)__builtin_amdgcn_mbcnt_hi(~0u, __builtin_amdgcn_mbcnt_lo(~0u, (unsigned)z)); }
__device__ __forceinline__ float sigmoidf_(float x) { return 1.f / (1.f + __expf(-x)); }

#define XB_TMO      128
#define XB_XCNT(j)  (256  + 64 * (j))
#define XB_XSUB(j)  (1280 + 64 * (j))
#define XB_XGEN(j)  (2304 + 64 * (j))
#define XB_TOP      3328
#define XB_TOPGEN   3392
#define XCD_BAR_WORDS 3456
#define XB_SPIN_CAP (1u << 18)
__device__ __forceinline__ unsigned xb_ld(unsigned* p)              { return __hip_atomic_load(p, __ATOMIC_RELAXED, __HIP_MEMORY_SCOPE_AGENT); }
__device__ __forceinline__ unsigned xb_add(unsigned* p, unsigned v) { return __hip_atomic_fetch_add(p, v, __ATOMIC_RELAXED, __HIP_MEMORY_SCOPE_AGENT); }
__device__ __forceinline__ unsigned xb_xcc_id() { return (unsigned)__builtin_amdgcn_s_getreg((3 << 11) | 20) & 0xFu; }
#define XB_SPIN(cond, bar) do { unsigned _sp = 0; while (cond) { __builtin_amdgcn_s_sleep(1); \
    if ((++_sp & 255u) == 0u) { if (xb_ld(&(bar)[XB_TMO])) break; if (_sp > XB_SPIN_CAP) { atomicAdd(&(bar)[XB_TMO], 1u); break; } } } } while (0)
struct XcdBarrier { unsigned* bar; unsigned x; volatile LAS unsigned* st; };
__device__ __forceinline__ XcdBarrier xcd_barrier_post(unsigned* bar, volatile LAS unsigned* st, int tid) {
    XcdBarrier b; b.bar = bar; b.x = xb_xcc_id(); b.st = st;
    if (tid == 0) (void)xb_add(&bar[XB_XCNT(b.x)], 1u);
    return b;
}
__device__ __forceinline__ void xcd_barrier_complete(unsigned* bar, unsigned x, unsigned& nloc, unsigned& nx) {
    const unsigned G = gridDim.x * gridDim.y * gridDim.z;
    unsigned sum, cnt, mine, sp = 0u;
    for (;;) {
        sum = 0u; cnt = 0u; mine = 0u;
#pragma unroll
        for (unsigned j = 0; j < 16; ++j) { const unsigned c = xb_ld(&bar[XB_XCNT(j)]); sum += c; cnt += (c > 0u) ? 1u : 0u; mine = (j == x) ? c : mine; }
        if (sum == G) break;
        __builtin_amdgcn_s_sleep(1);
        if ((++sp & 255u) == 0u) { if (xb_ld(&bar[XB_TMO])) break; if (sp > XB_SPIN_CAP) { atomicAdd(&bar[XB_TMO], 1u); break; } }
    }
    nloc = mine > 0u ? mine : 1u; nx = cnt > 0u ? cnt : 1u;
}
__device__ __forceinline__ void xcd_barrier(const XcdBarrier& b, int tid) {
    asm volatile("s_waitcnt vmcnt(0)" ::: "memory");
    __syncthreads();
    if (tid == 0) {
        unsigned* bar = b.bar;
        __builtin_amdgcn_s_waitcnt(0);
        unsigned nloc = b.st[0], nx = b.st[1];
        if (nloc == 0u) { xcd_barrier_complete(bar, b.x, nloc, nx); b.st[0] = nloc; b.st[1] = nx; }
        const unsigned old = xb_add(&bar[XB_XSUB(b.x)], 1u);
        const unsigned gen = old / nloc;
        if (old + 1u == (gen + 1u) * nloc) {
            __builtin_amdgcn_fence(__ATOMIC_RELEASE, "agent");
            asm volatile("s_waitcnt vmcnt(0)" ::: "memory");
            const unsigned og = xb_add(&bar[XB_TOP], 1u);
            const unsigned tg = og / nx;
            if (og + 1u == (tg + 1u) * nx) xb_add(&bar[XB_TOPGEN], 1u);
            else XB_SPIN(xb_ld(&bar[XB_TOPGEN]) == tg, bar);
            __builtin_amdgcn_fence(__ATOMIC_ACQUIRE, "agent");
            xb_add(&bar[XB_XGEN(b.x)], 1u);
            asm volatile("s_waitcnt vmcnt(0)" ::: "memory");
        } else {
            XB_SPIN(xb_ld(&bar[XB_XGEN(b.x)]) == gen, bar);
            __builtin_amdgcn_fence(__ATOMIC_ACQUIRE, "agent");
            asm volatile("s_waitcnt vmcnt(0)" ::: "memory");
        }
    }
    __syncthreads();
}

struct Args { const float* in[30]; float* out; unsigned char* ws; int ph_lo, ph_hi, use_bar, pad; };
#define CAS __attribute__((address_space(4)))
struct InTab {
    __device__ __forceinline__ const float* operator[](int i) const { return (const float*)(const __attribute__((address_space(1))) float*)((const CAS Args*)__builtin_amdgcn_kernarg_segment_ptr())->in[i]; }
};
struct Ctx {
    InTab in; __attribute__((address_space(1))) float* out; __attribute__((address_space(1))) unsigned char* ws;
    LAS unsigned char* lds; int tid, lane, wave, vcu, G;
    __device__ __forceinline__ unsigned char* wsp() const { return (unsigned char*)ws; }
    __device__ __forceinline__ float* outp() const { return (float*)out; }
    __device__ __forceinline__ unsigned* ctl() const { return (unsigned*)(ws + WS_CTL); }
    __device__ __forceinline__ float* mods(int l) const { return (float*)(ws + WS_MODS) + (size_t)l * 9 * 6144; }
    __device__ __forceinline__ float* ropec() const { return (float*)(ws + WS_ROPE); }
    __device__ __forceinline__ float* ropes() const { return (float*)(ws + WS_ROPE) + 4096 * 32; }
    __device__ __forceinline__ int* tok_e() const { return (int*)(ws + WS_TOK); }
    __device__ __forceinline__ float* tok_g() const { return (float*)(ws + WS_TOK) + 2 * T; }
    __device__ __forceinline__ int* tok_slot() const { return (int*)(ws + WS_TOK) + 4 * T; }
    __device__ __forceinline__ int* rowmap() const { return (int*)(ws + WS_RMAP); }
    __device__ __forceinline__ float* gslot() const { return (float*)(ws + WS_RMAP) + MAXSLOT; }
    __device__ __forceinline__ bf16* w_in_t(int l) const { return (bf16*)(ws + WS_WIN) + (size_t)l * INP * D; }
    __device__ __forceinline__ bf16* w_out_t(int l) const { return (bf16*)(ws + WS_WOUT) + (size_t)l * D * D; }
    __device__ __forceinline__ bf16* xn() const { return (bf16*)(ws + WS_XN); }
    __device__ __forceinline__ bf16* sgd() const { return (bf16*)(ws + WS_SGD); }
    __device__ __forceinline__ bf16* w2t(int l, int j) const { return (bf16*)(ws + WS_LORA) + (size_t)(l * 2 + j) * 512 * 64; }
    __device__ __forceinline__ bf16* a2t(int l, int j) const { return (bf16*)(ws + WS_LORA) + 131072 + (size_t)(l * 2 + j) * 512 * 64; }
    __device__ __forceinline__ bf16* g2t(int l) const { return (bf16*)(ws + WS_LORA) + 262144 + (size_t)l * 512 * 128; }
    __device__ __forceinline__ bf16* qkv() const { return (bf16*)(ws + WS_QKV); }
    __device__ __forceinline__ bf16* ur() const { return (bf16*)(ws + WS_UR); }
    __device__ __forceinline__ bf16* ybuf() const { return (bf16*)(ws + WS_Y); }
    __device__ __forceinline__ bf16* sc() const { return (bf16*)(ws + WS_BIG); }
    __device__ __forceinline__ bf16* wgu() const { return (bf16*)(ws + WS_WGU); }
    __device__ __forceinline__ bf16* wdn() const { return (bf16*)(ws + WS_WDN); }
    __device__ __forceinline__ bf16* hmid() const { return (bf16*)(ws + WS_HMID); }
    __device__ __forceinline__ float* hc() const { return (float*)(ws + WS_HC); }
    __device__ __forceinline__ float* hrow(int row) const { return row < TL ? outp() + (size_t)row * D : hc() + (size_t)(row - TL) * D; }
    __device__ __forceinline__ bf16* hb(int row) const { return row < TL ? (bf16*)outp() + (size_t)row * 2048 : (bf16*)hc() + (size_t)(row - TL) * D; }
    __device__ __forceinline__ const float* xrow(int row) const { return row < TL ? in[0] + (size_t)row * D : in[2] + (size_t)(row - TL) * D; }
};
__device__ __forceinline__ int sample_of(int row) { return row < TL ? (row >> 12) : 8; }

typedef pg8::f32x4 pf4;
struct EpiIn {
    static constexpr bool PERM = true;
    bf16* QKV; bf16* UR;
    __device__ __forceinline__ void operator()(const pf4 (&acc)[2][2][4][2], const pg8::Unit& u, int wr, int wc, int fr, int fq) const {
        const int row0 = u.pm * 256 + wr * 64 + fr;
        bf16* base; int ld, colt;
        if (u.pn < 4) { base = QKV; ld = D; colt = u.pn * 256; } else { base = UR; ld = URP; colt = (u.pn - 4) * 256; }
        const int col0 = colt + wc * 32 + 8 * fq;
#pragma unroll
        for (int ai = 0; ai < 2; ++ai)
#pragma unroll
            for (int m = 0; m < 4; ++m) { bf16* rowp = base + (size_t)(row0 + ai * 128 + m * 16) * ld + col0;
#pragma unroll
                for (int bj = 0; bj < 2; ++bj) { const pf4 v0 = acc[ai][bj][m][0], v1 = acc[ai][bj][m][1]; v4u w;
                    w.x = pg8::cvt_pk_bf16(v0[0], v0[1]); w.y = pg8::cvt_pk_bf16(v0[2], v0[3]); w.z = pg8::cvt_pk_bf16(v1[0], v1[1]); w.w = pg8::cvt_pk_bf16(v1[2], v1[3]);
                    *(v4u*)(rowp + bj * 128) = w; } }
    }
};
struct EpiOut {
    static constexpr bool PERM = true;
    bf16* hb_lat; bf16* hb_ctx; const float* gmix;
    __device__ __forceinline__ void operator()(const pf4 (&acc)[2][2][4][2], const pg8::Unit& u, int wr, int wc, int fr, int fq) const {
        const int r0 = u.pm * 256; const bool isc = r0 >= TL; const int s = isc ? 8 : (r0 >> 12);
        bf16* op = isc ? hb_ctx + (size_t)(r0 - TL) * D : hb_lat + (size_t)r0 * 2048; const size_t opitch = isc ? (size_t)D : (size_t)2048;
        const int col0 = u.pn * 256 + wc * 32 + 8 * fq; const float* gp = gmix + (size_t)s * 6144 + col0;
        pf4 gv[2][2];
#pragma unroll
        for (int bj = 0; bj < 2; ++bj)
#pragma unroll
            for (int n = 0; n < 2; ++n) gv[bj][n] = *(const pf4*)(gp + bj * 128 + 4 * n);
        constexpr int EPD = 3;
        v4u q[8][2];
#pragma unroll
        for (int g = 0; g < 8 + EPD; ++g) {
            if (g < 8) { const bf16* irow = op + (size_t)((g >> 2) * 128 + wr * 64 + (g & 3) * 16 + fr) * opitch + col0;
#pragma unroll
                for (int bj = 0; bj < 2; ++bj) q[g][bj] = *(const v4u*)(irow + bj * 128); }
            if (g >= EPD) { const int h = g - EPD; bf16* orow = op + (size_t)((h >> 2) * 128 + wr * 64 + (h & 3) * 16 + fr) * opitch + col0;
#pragma unroll
                for (int bj = 0; bj < 2; ++bj) { const v4u b = q[h][bj]; const pf4 b0 = {bflo(b.x), bfhi(b.x), bflo(b.y), bfhi(b.y)}, b1 = {bflo(b.z), bfhi(b.z), bflo(b.w), bfhi(b.w)};
                    const pf4 v0 = b0 + gv[bj][0] * acc[h >> 2][bj][h & 3][0], v1 = b1 + gv[bj][1] * acc[h >> 2][bj][h & 3][1]; v4u w;
                    w.x = pg8::cvt_pk_bf16(v0[0], v0[1]); w.y = pg8::cvt_pk_bf16(v0[2], v0[3]); w.z = pg8::cvt_pk_bf16(v1[0], v1[1]); w.w = pg8::cvt_pk_bf16(v1[2], v1[3]);
                    *(v4u*)(orow + bj * 128) = w; } }
            asm volatile("" ::: "memory"); }
    }
};
struct EpiGU {
    static constexpr bool PERM = true;
    bf16* H;
    __device__ __forceinline__ void operator()(const pf4 (&acc)[2][2][4][2], const pg8::Unit& u, int wr, int wc, int fr, int fq) const {
        const int row0 = u.pm * 256 + wr * 64 + fr; const int col0 = (u.pn & 7) * 128 + wc * 32 + 8 * fq;
#pragma unroll
        for (int ai = 0; ai < 2; ++ai)
#pragma unroll
            for (int m = 0; m < 4; ++m) { float h[8];
#pragma unroll
                for (int n = 0; n < 2; ++n)
#pragma unroll
                    for (int i = 0; i < 4; ++i) { const float gt = acc[ai][0][m][n][i], up = acc[ai][1][m][n][i]; h[n * 4 + i] = gt * __builtin_amdgcn_rcpf(1.f + __expf(-gt)) * up; }
                v4u w; w.x = pg8::cvt_pk_bf16(h[0], h[1]); w.y = pg8::cvt_pk_bf16(h[2], h[3]); w.z = pg8::cvt_pk_bf16(h[4], h[5]); w.w = pg8::cvt_pk_bf16(h[6], h[7]);
                *(v4u*)(H + (size_t)(row0 + ai * 128 + m * 16) * D + col0) = w; }
    }
};
struct EpiDN {
    static constexpr bool PERM = true;
    bf16* Y; const float* gs;
    __device__ __forceinline__ void operator()(const pf4 (&acc)[2][2][4][2], const pg8::Unit& u, int wr, int wc, int fr, int fq) const {
        const int row0 = u.pm * 256 + wr * 64 + fr; const int col0 = (u.pn & 3) * 256 + wc * 32 + 8 * fq;
        float g8[8];
#pragma unroll
        for (int i = 0; i < 8; ++i) g8[i] = gs[row0 + (i >> 2) * 128 + (i & 3) * 16];
        asm volatile("" : "+v"(g8[0]), "+v"(g8[1]), "+v"(g8[2]), "+v"(g8[3]), "+v"(g8[4]), "+v"(g8[5]), "+v"(g8[6]), "+v"(g8[7]));
#pragma unroll
        for (int ai = 0; ai < 2; ++ai)
#pragma unroll
            for (int m = 0; m < 4; ++m) { const int row = row0 + ai * 128 + m * 16; const float gt = g8[ai * 4 + m]; bf16* rowp = Y + (size_t)row * D + col0;
#pragma unroll
                for (int bj = 0; bj < 2; ++bj) { const pf4 v0 = acc[ai][bj][m][0] * gt, v1 = acc[ai][bj][m][1] * gt; v4u w;
                    w.x = pg8::cvt_pk_bf16(v0[0], v0[1]); w.y = pg8::cvt_pk_bf16(v0[2], v0[3]); w.z = pg8::cvt_pk_bf16(v1[0], v1[1]); w.w = pg8::cvt_pk_bf16(v1[2], v1[3]);
                    *(v4u*)(rowp + bj * 128) = w; } }
    }
};

__device__ __forceinline__ void transpose_item(const float* W, int K, int N, bf16* WT, int k0, int n0, int drow0, LAS float* scr, int lane) {
#pragma unroll
    for (int i0 = 0; i0 < 32; i0 += 16) { float tw[16];
#pragma unroll
        for (int i = 0; i < 16; ++i) { const int kk = 2 * (i0 + i) + (lane >> 5); tw[i] = W[(size_t)(k0 + kk) * N + n0 + (lane & 31)]; }
        asm volatile("" : "+v"(tw[0]), "+v"(tw[1]), "+v"(tw[2]), "+v"(tw[3]), "+v"(tw[4]), "+v"(tw[5]), "+v"(tw[6]), "+v"(tw[7]), "+v"(tw[8]), "+v"(tw[9]), "+v"(tw[10]), "+v"(tw[11]), "+v"(tw[12]), "+v"(tw[13]), "+v"(tw[14]), "+v"(tw[15]));
#pragma unroll
        for (int i = 0; i < 16; ++i) { const int kk = 2 * (i0 + i) + (lane >> 5); scr[kk * 33 + (lane & 31)] = tw[i]; } }
    LDS_WAIT(); asm volatile("" ::: "memory");
    const int c = lane & 7;
#pragma unroll
    for (int j = 0; j < 4; ++j) { const int n = (lane >> 3) + 8 * j; const LAS float* s = scr + (8 * c) * 33 + n;
        v4u o; o.x = pk2(s[0 * 33], s[1 * 33]); o.y = pk2(s[2 * 33], s[3 * 33]); o.z = pk2(s[4 * 33], s[5 * 33]); o.w = pk2(s[6 * 33], s[7 * 33]);
        *(v4u*)(WT + (size_t)(drow0 + n) * K + k0 + 8 * c) = o; }
    LDS_WAIT(); asm volatile("" ::: "memory");
}
__device__ __forceinline__ void transpose_item64(const float* W, int K, int N, bf16* WT, int k0, int n0, int drow0, LAS unsigned* scr, int lane) {
    f32x4 ta[8], tb[8];
#pragma unroll
    for (int i = 0; i < 8; ++i) { const int idx = i * 64 + lane, kp = idx >> 4, n4 = idx & 15;
        ta[i] = *(const f32x4*)(W + (size_t)(k0 + 2 * kp) * N + n0 + 4 * n4); tb[i] = *(const f32x4*)(W + (size_t)(k0 + 2 * kp + 1) * N + n0 + 4 * n4); }
    asm volatile("" : "+v"(ta[0]), "+v"(ta[1]), "+v"(ta[2]), "+v"(ta[3]), "+v"(ta[4]), "+v"(ta[5]), "+v"(ta[6]), "+v"(ta[7]), "+v"(tb[0]), "+v"(tb[1]), "+v"(tb[2]), "+v"(tb[3]), "+v"(tb[4]), "+v"(tb[5]), "+v"(tb[6]), "+v"(tb[7]));
#pragma unroll
    for (int i = 0; i < 8; ++i) { const int idx = i * 64 + lane, kp = idx >> 4, n4 = idx & 15; const f32x4 a = ta[i], b = tb[i];
        scr[(4 * n4 + 0) * 33 + kp] = pk2(a.x, b.x); scr[(4 * n4 + 1) * 33 + kp] = pk2(a.y, b.y); scr[(4 * n4 + 2) * 33 + kp] = pk2(a.z, b.z); scr[(4 * n4 + 3) * 33 + kp] = pk2(a.w, b.w); }
    LDS_WAIT(); asm volatile("" ::: "memory");
    const int c = lane & 7;
#pragma unroll
    for (int j = 0; j < 8; ++j) { const int n = (lane >> 3) + 8 * j; const LAS unsigned* sp = scr + n * 33 + 4 * c;
        v4u o; o.x = sp[0]; o.y = sp[1]; o.z = sp[2]; o.w = sp[3];
        *(v4u*)(WT + (size_t)(drow0 + n) * K + k0 + 8 * c) = o; }
    LDS_WAIT(); asm volatile("" ::: "memory");
}
__device__ __forceinline__ int win_dest_row(int n0) {
    if (n0 < 256) return n0;
    if (n0 < 384) return 512 + (n0 - 256);
    if (n0 < 512) return 640 + (n0 - 384);
    if (n0 < 768) return 256 + (n0 - 512);
    return n0;
}
__device__ __forceinline__ void phase_prologue(const Ctx& C) {
    LAS float* scr = (LAS float*)(C.lds + C.wave * 16384);
    const int gw = C.vcu * NWAVES + C.wave, NGW = C.G * NWAVES;
    constexpr int I_IN = (D / 64) * (INC / 32), I_OUT = (D / 64) * (D / 32), I_L = I_IN + I_OUT;
    for (int it = gw; it < DEPTH * I_L; it += NGW) {
        const int l = it / I_L; int r = it % I_L;
        if (r < I_IN) { const int nblk = INC / 32, kb = r / nblk, nb = r % nblk; transpose_item(C.in[8] + (size_t)l * D * INC, D, INC, C.w_in_t(l), 64 * kb, 32 * nb, win_dest_row(32 * nb), scr, C.lane); }
        else { r -= I_IN; const int nblk = D / 32, kb = r / nblk, nb = r % nblk; transpose_item(C.in[23] + (size_t)l * D * D, D, D, C.w_out_t(l), 64 * kb, 32 * nb, 32 * nb, scr, C.lane); }
    }
    { const int gt = C.vcu * 512 + C.tid, NGT = C.G * 512;
      for (int i = gt; i < DEPTH * 128 * D / 8; i += NGT) { const int l = i / (128 * D / 8), r = i % (128 * D / 8); *(v4u*)(C.w_in_t(l) + (size_t)INC * D + (size_t)r * 8) = (v4u){0u, 0u, 0u, 0u}; }
      for (int i = gt; i < 2 * 2 * 512 * 64; i += NGT) { const int r = i & 63, c = (i >> 6) & 511, lj = i >> 15;
          ((bf16*)(C.wsp() + WS_LORA))[i] = (bf16)f2bf(C.in[14][((size_t)lj * 64 + r) * 512 + c]); ((bf16*)(C.wsp() + WS_LORA))[131072 + i] = (bf16)f2bf(C.in[16][((size_t)lj * 64 + r) * 512 + c]); }
      for (int i = gt; i < 2 * 512 * 128; i += NGT) { const int q = i & 127, c = (i >> 7) & 511, l = i >> 16; ((bf16*)(C.wsp() + WS_LORA))[262144 + i] = (bf16)f2bf(C.in[17][((size_t)l * 128 + q) * 512 + c]); }
      for (int i = gt; i < 4096 * 32; i += NGT) { const int t = i >> 5, p = i & 31; const float pos = (float)(p < 16 ? (t >> 6) : (t & 63)); const float inv = powf(10000.f, -(float)(p & 15) / 16.f);
          const float ang = pos * inv; C.ropec()[i] = cosf(ang); C.ropes()[i] = sinf(ang); }
    }
    __syncthreads();
    for (int it = C.vcu; it < DEPTH * 96; it += C.G) {
        const int l = it / 96, n0 = (it % 96) * 64;
        LAS float* sc = (LAS float*)C.lds;
        LAS float* part = (LAS float*)(C.lds + 40960);
        for (int i = C.tid; i < 9 * 1024; i += 512) { const int s = i >> 10, k = i & 1023; const float v = s < 8 ? C.in[1][s * 1024 + k] : C.in[3][k]; sc[i] = v / (1.f + __expf(-v)); }
        __syncthreads();
        float a[9];
#pragma unroll
        for (int s = 0; s < 9; ++s) a[s] = 0.f;
        const float* wp = C.in[4] + (size_t)l * D * 6144 + n0 + C.lane;
        for (int k0 = C.wave * 128; k0 < C.wave * 128 + 128; k0 += 16) { float w[16];
#pragma unroll
            for (int i = 0; i < 16; ++i) w[i] = wp[(size_t)(k0 + i) * 6144];
            asm volatile("" : "+v"(w[0]), "+v"(w[1]), "+v"(w[2]), "+v"(w[3]), "+v"(w[4]), "+v"(w[5]), "+v"(w[6]), "+v"(w[7]), "+v"(w[8]), "+v"(w[9]), "+v"(w[10]), "+v"(w[11]), "+v"(w[12]), "+v"(w[13]), "+v"(w[14]), "+v"(w[15]));
#pragma unroll
            for (int i = 0; i < 16; ++i)
#pragma unroll
                for (int s = 0; s < 9; ++s) a[s] += sc[s * 1024 + k0 + i] * w[i]; }
#pragma unroll
        for (int s = 0; s < 9; ++s) part[(C.wave * 9 + s) * 64 + C.lane] = a[s];
        __syncthreads();
        for (int i = C.tid; i < 9 * 64; i += 512) { const int s = i >> 6, n = i & 63; float v = C.in[5][l * 6144 + n0 + n];
#pragma unroll
            for (int w = 0; w < 8; ++w) v += part[(w * 9 + s) * 64 + n];
            C.mods(l)[s * 6144 + n0 + n] = v; }
        __syncthreads();
    }
}
__device__ __forceinline__ void phase_wconv(const Ctx& C, int l) {
    LAS unsigned* scr = (LAS unsigned*)(C.lds + C.wave * 16384);
    const int gw = C.vcu * NWAVES + C.wave, NGW = C.G * NWAVES;
    constexpr int I_M = (D / 64) * (D / 64);
    for (int it = gw; it < NEXP * 3 * I_M; it += NGW) {
        const int e = it / (3 * I_M), r3 = it % (3 * I_M), which = r3 / I_M, r = r3 % I_M, kb = r / 16, nb = r % 16, n0 = 64 * nb;
        const size_t eoff = ((size_t)l * NEXP + e) * D * D;
        if (which == 0) transpose_item64(C.in[26] + eoff, D, D, C.wgu() + (size_t)e * 2048 * D, 64 * kb, n0, 256 * (n0 >> 7) + (n0 & 127), scr, C.lane);
        else if (which == 1) transpose_item64(C.in[27] + eoff, D, D, C.wgu() + (size_t)e * 2048 * D, 64 * kb, n0, 256 * (n0 >> 7) + 128 + (n0 & 127), scr, C.lane);
        else transpose_item64(C.in[28] + eoff, D, D, C.wdn() + (size_t)e * D * D, 64 * kb, n0, n0, scr, C.lane);
    }
}

__device__ __forceinline__ void store_row_bf16(bf16* orow, const f32x4 (&v)[4], int lane) {
    v2u* o8 = (v2u*)orow + lane;
#pragma unroll
    for (int j = 0; j < 4; ++j) { v2u w; w.x = pk2(v[j].x, v[j].y); w.y = pk2(v[j].z, v[j].w); o8[64 * j] = w; }
}
__device__ __forceinline__ void add_yrow(f32x4 (&v)[4], const bf16* yrow, const f32x4 (&g)[4], int lane) {
    const v2u* y8 = (const v2u*)yrow + lane;
#pragma unroll
    for (int j = 0; j < 4; ++j) { const v2u w = y8[64 * j]; v[j].x += g[j].x * bflo(w.x); v[j].y += g[j].y * bfhi(w.x); v[j].z += g[j].z * bflo(w.y); v[j].w += g[j].w * bfhi(w.y); }
}
__device__ __forceinline__ void phase_norm1(const Ctx& C, int l) {
    const int gw = C.vcu * NWAVES + C.wave, NGW = C.G * NWAVES;
    const float* g = C.in[6] + l * D;
    for (int row0 = gw; row0 < T; row0 += 2 * NGW) {
        f32x4 v[2][4]; int sl[2][2]; bool ok[2]; int sm[2];
#pragma unroll
        for (int r = 0; r < 2; ++r) { const int row = row0 + r * NGW; ok[r] = row < T; const int rw = ok[r] ? row : row0; sm[r] = sample_of(rw);
            if (l == 0) { const f32x4* xr = (const f32x4*)C.xrow(rw) + C.lane;
#pragma unroll
                for (int j = 0; j < 4; ++j) v[r][j] = xr[64 * j]; }
            else { const v2u* hr = (const v2u*)C.hb(rw) + C.lane;
#pragma unroll
                for (int j = 0; j < 4; ++j) { const v2u w_ = hr[64 * j]; v[r][j] = (f32x4){bflo(w_.x), bfhi(w_.x), bflo(w_.y), bfhi(w_.y)}; }
                sl[r][0] = C.tok_slot()[2 * rw]; sl[r][1] = C.tok_slot()[2 * rw + 1]; } }
        f32x4 gq[4], sq[2][4], hq[2][4];
        { const f32x4* gp = (const f32x4*)g + C.lane;
#pragma unroll
          for (int j = 0; j < 4; ++j) gq[j] = gp[64 * j];
#pragma unroll
          for (int r = 0; r < 2; ++r) { const f32x4* shp = (const f32x4*)(C.mods(l) + (size_t)sm[r] * 6144) + C.lane; const f32x4* scp = (const f32x4*)(C.mods(l) + (size_t)sm[r] * 6144 + 1024) + C.lane;
#pragma unroll
              for (int j = 0; j < 4; ++j) { hq[r][j] = shp[64 * j]; sq[r][j] = scp[64 * j]; } } }
        if (l != 0) {
            v2u y[2][2][4]; f32x4 gf[2][4];
#pragma unroll
            for (int r = 0; r < 2; ++r) { const f32x4* gp = (const f32x4*)(C.mods(l - 1) + (size_t)sm[r] * 6144 + 5 * 1024) + C.lane;
#pragma unroll
                for (int k = 0; k < 2; ++k) { const v2u* y8 = (const v2u*)(C.ybuf() + (size_t)sl[r][k] * D) + C.lane;
#pragma unroll
                    for (int j = 0; j < 4; ++j) y[r][k][j] = y8[64 * j]; }
#pragma unroll
                for (int j = 0; j < 4; ++j) gf[r][j] = gp[64 * j]; }
            asm volatile("" : "+v"(v[0][0]), "+v"(v[0][1]), "+v"(v[0][2]), "+v"(v[0][3]), "+v"(v[1][0]), "+v"(v[1][1]), "+v"(v[1][2]), "+v"(v[1][3]));
            asm volatile("" : "+v"(y[0][0][0]), "+v"(y[0][0][1]), "+v"(y[0][0][2]), "+v"(y[0][0][3]), "+v"(y[0][1][0]), "+v"(y[0][1][1]), "+v"(y[0][1][2]), "+v"(y[0][1][3]), "+v"(y[1][0][0]), "+v"(y[1][0][1]), "+v"(y[1][0][2]), "+v"(y[1][0][3]), "+v"(y[1][1][0]), "+v"(y[1][1][1]), "+v"(y[1][1][2]), "+v"(y[1][1][3]), "+v"(gf[0][0]), "+v"(gf[0][1]), "+v"(gf[0][2]), "+v"(gf[0][3]), "+v"(gf[1][0]), "+v"(gf[1][1]), "+v"(gf[1][2]), "+v"(gf[1][3]));
#pragma unroll
            for (int r = 0; r < 2; ++r) {
#pragma unroll
                for (int k = 0; k < 2; ++k)
#pragma unroll
                    for (int j = 0; j < 4; ++j) { const v2u w = y[r][k][j]; v[r][j].x += gf[r][j].x * bflo(w.x); v[r][j].y += gf[r][j].y * bfhi(w.x); v[r][j].z += gf[r][j].z * bflo(w.y); v[r][j].w += gf[r][j].w * bfhi(w.y); }
                if (ok[r]) store_row_bf16(C.hb(row0 + r * NGW), v[r], C.lane); }
        }
        if (l == 0) { asm volatile("" : "+v"(v[0][0]), "+v"(v[0][1]), "+v"(v[0][2]), "+v"(v[0][3]), "+v"(v[1][0]), "+v"(v[1][1]), "+v"(v[1][2]), "+v"(v[1][3]));
#pragma unroll
            for (int r = 0; r < 2; ++r) if (ok[r]) store_row_bf16(C.hb(row0 + r * NGW), v[r], C.lane); }
#pragma unroll
        for (int r = 0; r < 2; ++r) {
            float ss = 0.f;
#pragma unroll
            for (int j = 0; j < 4; ++j) ss += (v[r][j].x * v[r][j].x + v[r][j].y * v[r][j].y) + (v[r][j].z * v[r][j].z + v[r][j].w * v[r][j].w);
            const float rstd = 1.f / sqrtf(wave_sum(ss) * (1.f / D) + 1e-6f);
            if (r == 0) asm volatile("" : "+v"(gq[0]), "+v"(gq[1]), "+v"(gq[2]), "+v"(gq[3]), "+v"(sq[0][0]), "+v"(sq[0][1]), "+v"(sq[0][2]), "+v"(sq[0][3]), "+v"(sq[1][0]), "+v"(sq[1][1]), "+v"(sq[1][2]), "+v"(sq[1][3]), "+v"(hq[0][0]), "+v"(hq[0][1]), "+v"(hq[0][2]), "+v"(hq[0][3]), "+v"(hq[1][0]), "+v"(hq[1][1]), "+v"(hq[1][2]), "+v"(hq[1][3]));
#pragma unroll
            for (int j = 0; j < 4; ++j) v[r][j] = (v[r][j] * rstd * gq[j]) * (1.f + sq[r][j]) + hq[r][j];
            if (ok[r]) store_row_bf16(C.xn() + (size_t)(row0 + r * NGW) * D, v[r], C.lane);
        }
    }
}
__device__ __forceinline__ void phase_final(const Ctx& C) {
    const int gw = C.vcu * NWAVES + C.wave, NGW = C.G * NWAVES;
    for (int row0 = gw; row0 < TL; row0 += 2 * NGW) {
        f32x4 v[2][4]; int sl[2][2]; bool ok[2]; int sm[2];
#pragma unroll
        for (int r = 0; r < 2; ++r) { const int row = row0 + r * NGW; ok[r] = row < TL; const int rw = ok[r] ? row : row0; sm[r] = rw >> 12;
            const v2u* hr = (const v2u*)C.hb(rw) + C.lane;
#pragma unroll
            for (int j = 0; j < 4; ++j) { const v2u w_ = hr[64 * j]; v[r][j] = (f32x4){bflo(w_.x), bfhi(w_.x), bflo(w_.y), bfhi(w_.y)}; }
            sl[r][0] = C.tok_slot()[2 * rw]; sl[r][1] = C.tok_slot()[2 * rw + 1]; }
        v2u y[2][2][4]; f32x4 gf[2][4];
#pragma unroll
        for (int r = 0; r < 2; ++r) { const f32x4* gp = (const f32x4*)(C.mods(1) + (size_t)sm[r] * 6144 + 5 * 1024) + C.lane;
#pragma unroll
            for (int k = 0; k < 2; ++k) { const v2u* y8 = (const v2u*)(C.ybuf() + (size_t)sl[r][k] * D) + C.lane;
#pragma unroll
                for (int j = 0; j < 4; ++j) y[r][k][j] = y8[64 * j]; }
#pragma unroll
            for (int j = 0; j < 4; ++j) gf[r][j] = gp[64 * j]; }
        const f32x4* fg = (const f32x4*)C.in[29] + C.lane; f32x4 fq[4];
#pragma unroll
        for (int j = 0; j < 4; ++j) fq[j] = fg[64 * j];
        asm volatile("" : "+v"(v[0][0]), "+v"(v[0][1]), "+v"(v[0][2]), "+v"(v[0][3]), "+v"(v[1][0]), "+v"(v[1][1]), "+v"(v[1][2]), "+v"(v[1][3]));
        asm volatile("" : "+v"(y[0][0][0]), "+v"(y[0][0][1]), "+v"(y[0][0][2]), "+v"(y[0][0][3]), "+v"(y[0][1][0]), "+v"(y[0][1][1]), "+v"(y[0][1][2]), "+v"(y[0][1][3]), "+v"(y[1][0][0]), "+v"(y[1][0][1]), "+v"(y[1][0][2]), "+v"(y[1][0][3]), "+v"(y[1][1][0]), "+v"(y[1][1][1]), "+v"(y[1][1][2]), "+v"(y[1][1][3]), "+v"(gf[0][0]), "+v"(gf[0][1]), "+v"(gf[0][2]), "+v"(gf[0][3]), "+v"(gf[1][0]), "+v"(gf[1][1]), "+v"(gf[1][2]), "+v"(gf[1][3]));
        asm volatile("" : "+v"(fq[0]), "+v"(fq[1]), "+v"(fq[2]), "+v"(fq[3]));
#pragma unroll
        for (int r = 0; r < 2; ++r) {
#pragma unroll
            for (int k = 0; k < 2; ++k)
#pragma unroll
                for (int j = 0; j < 4; ++j) { const v2u w = y[r][k][j]; v[r][j].x += gf[r][j].x * bflo(w.x); v[r][j].y += gf[r][j].y * bfhi(w.x); v[r][j].z += gf[r][j].z * bflo(w.y); v[r][j].w += gf[r][j].w * bfhi(w.y); }
            float ss = 0.f;
#pragma unroll
            for (int j = 0; j < 4; ++j) ss += (v[r][j].x * v[r][j].x + v[r][j].y * v[r][j].y) + (v[r][j].z * v[r][j].z + v[r][j].w * v[r][j].w);
            const float rstd = 1.f / sqrtf(wave_sum(ss) * (1.f / D) + 1e-6f);
            if (ok[r]) { f32x4* hr = (f32x4*)(C.outp() + (size_t)(row0 + r * NGW) * D) + C.lane;
#pragma unroll
                for (int j = 0; j < 4; ++j) hr[64 * j] = v[r][j] * rstd * fq[j]; }
        }
    }
}
#define DPPX(v, ctrl) __builtin_bit_cast(float, __builtin_amdgcn_update_dpp(0, __builtin_bit_cast(int, (v)), (ctrl), 0xf, 0xf, true))
#define SWZX(v, pat) __builtin_bit_cast(float, __builtin_amdgcn_ds_swizzle(__builtin_bit_cast(int, (v)), (pat)))
__device__ __forceinline__ void phase_norm2(const Ctx& C, int l) {
    const int gw = C.vcu * NWAVES + C.wave, NGW = C.G * NWAVES;
    const int ntok = (l == 0) ? T : TL;
    LAS int* hist = (LAS int*)(C.lds + LDSCTL_OFF) + 32;
    LAS float* wl = (LAS float*)C.lds;
    LAS float* lgs = (LAS float*)(C.lds + 65536) + C.wave * 16;
    if (C.tid < 16) hist[C.tid] = 0;
    { const float* wr = C.in[24];
#pragma unroll
      for (int i0 = 0; i0 < 32; i0 += 16) { float tw[16];
#pragma unroll
          for (int i = 0; i < 16; ++i) tw[i] = wr[C.tid + 512 * (i0 + i)];
          asm volatile("" : "+v"(tw[0]), "+v"(tw[1]), "+v"(tw[2]), "+v"(tw[3]), "+v"(tw[4]), "+v"(tw[5]), "+v"(tw[6]), "+v"(tw[7]), "+v"(tw[8]), "+v"(tw[9]), "+v"(tw[10]), "+v"(tw[11]), "+v"(tw[12]), "+v"(tw[13]), "+v"(tw[14]), "+v"(tw[15]));
#pragma unroll
          for (int i = 0; i < 16; ++i) { const int idx = C.tid + 512 * (i0 + i); wl[(idx & 15) * 1024 + (idx >> 4)] = tw[i]; } } }
    __syncthreads();
    const float* g = C.in[7] + l * D; const float* rb = C.in[25];
    const int lane = C.lane; const bool b0 = lane & 1, b1 = lane & 2, b2 = lane & 4, b3 = lane & 8;
    const int myexp = 8 * (lane & 1) + 4 * ((lane >> 1) & 1) + 2 * ((lane >> 2) & 1) + ((lane >> 3) & 1);
    const int gi = myexp >> 2, wi = myexp & 3; const float rbl = rb[myexp];
    for (int row = gw; row < ntok; row += NGW) {
        const int s = sample_of(row);
        f32x4 v[4], gq[4], sq[4], hq[4]; v2u hv[4]; const v2u* hr = (const v2u*)C.hb(row) + lane;
        const f32x4* gp = (const f32x4*)g + lane; const f32x4* shp = (const f32x4*)(C.mods(l) + (size_t)s * 6144 + 3 * 1024) + lane; const f32x4* scp = (const f32x4*)(C.mods(l) + (size_t)s * 6144 + 4 * 1024) + lane;
#pragma unroll
        for (int j = 0; j < 4; ++j) { hv[j] = hr[64 * j]; gq[j] = gp[64 * j]; sq[j] = scp[64 * j]; hq[j] = shp[64 * j]; }
        asm volatile("" : "+v"(hv[0]), "+v"(hv[1]), "+v"(hv[2]), "+v"(hv[3]), "+v"(gq[0]), "+v"(gq[1]), "+v"(gq[2]), "+v"(gq[3]), "+v"(sq[0]), "+v"(sq[1]), "+v"(sq[2]), "+v"(sq[3]), "+v"(hq[0]), "+v"(hq[1]), "+v"(hq[2]), "+v"(hq[3]));
#pragma unroll
        for (int j = 0; j < 4; ++j) v[j] = (f32x4){bflo(hv[j].x), bfhi(hv[j].x), bflo(hv[j].y), bfhi(hv[j].y)};
        float ss = 0.f;
#pragma unroll
        for (int j = 0; j < 4; ++j) ss += (v[j].x * v[j].x + v[j].y * v[j].y) + (v[j].z * v[j].z + v[j].w * v[j].w);
        const float rstd = 1.f / sqrtf(wave_sum(ss) * (1.f / D) + 1e-6f);
#pragma unroll
        for (int j = 0; j < 4; ++j) v[j] = (v[j] * rstd * gq[j]) * (1.f + sq[j]) + hq[j];
        store_row_bf16(C.xn() + (size_t)row * D, v, lane);
        float lg[16];
#pragma unroll
        for (int eg = 0; eg < 4; ++eg) {
            f32x4 w[16];
#pragma unroll
            for (int i = 0; i < 16; ++i) w[i] = *(const LAS f32x4*)(wl + (4 * eg + (i >> 2)) * 1024 + 256 * (i & 3) + 4 * lane);
            asm volatile("" : "+v"(w[0]), "+v"(w[1]), "+v"(w[2]), "+v"(w[3]), "+v"(w[4]), "+v"(w[5]), "+v"(w[6]), "+v"(w[7]), "+v"(w[8]), "+v"(w[9]), "+v"(w[10]), "+v"(w[11]), "+v"(w[12]), "+v"(w[13]), "+v"(w[14]), "+v"(w[15]));
#pragma unroll
            for (int e4 = 0; e4 < 4; ++e4) { typedef float f32x2 __attribute__((ext_vector_type(2))); f32x2 a2 = {0.f, 0.f};
#pragma unroll
                for (int j = 0; j < 4; ++j) { const f32x4 ww = w[4 * e4 + j]; a2 += (f32x2){v[j].x, v[j].y} * (f32x2){ww.x, ww.y}; a2 += (f32x2){v[j].z, v[j].w} * (f32x2){ww.z, ww.w}; }
                lg[4 * eg + e4] = a2.x + a2.y; } }
        float a8[8], a4[4], a2[2];
#pragma unroll
        for (int i = 0; i < 8; ++i) { const float send = b0 ? lg[i] : lg[i + 8], keep = b0 ? lg[i + 8] : lg[i]; a8[i] = keep + DPPX(send, 0xB1); }
#pragma unroll
        for (int i = 0; i < 4; ++i) { const float send = b1 ? a8[i] : a8[i + 4], keep = b1 ? a8[i + 4] : a8[i]; a4[i] = keep + DPPX(send, 0x4E); }
#pragma unroll
        for (int i = 0; i < 2; ++i) { const float send = b2 ? a4[i] : a4[i + 2], keep = b2 ? a4[i + 2] : a4[i]; a2[i] = keep + SWZX(send, 0x101F); }
        float a1; { const float send = b3 ? a2[0] : a2[1], keep = b3 ? a2[1] : a2[0]; a1 = keep + SWZX(send, 0x201F); }
        a1 += SWZX(a1, 0x401F);
        a1 = half_sum2(a1);
        { const float sg = 1.f / (1.f + expf(-a1)), bb = sg + rbl;
          const int la4 = (lane ^ 4) << 2, la8 = (lane ^ 8) << 2, la12 = (lane ^ 12) << 2;
#define BPERM(a, v) __builtin_bit_cast(float, __builtin_amdgcn_ds_bpermute((a), __builtin_bit_cast(int, (v))))
          const float v1 = BPERM(la4, bb), v2 = BPERM(la8, bb), v3 = BPERM(la12, bb);
          const float hi1 = fmaxf(bb, v1), lo1 = fminf(bb, v1), hi2 = fmaxf(v2, v3), lo2 = fminf(v2, v3);
          const float gs = fmaxf(hi1, hi2) + fmaxf(fminf(hi1, hi2), fmaxf(lo1, lo2));
          const float q1 = DPPX(gs, 0xB1), q2 = DPPX(gs, 0x4E), q3 = DPPX(gs, 0x1B);
          const bool best = (gs > q1 || (gs == q1 && gi < (gi ^ 2))) && (gs > q2 || (gs == q2 && gi < (gi ^ 1))) && (gs > q3 || (gs == q3 && gi < (gi ^ 3)));
          const int rank = ((v1 > bb || (v1 == bb && (wi ^ 2) < wi)) ? 1 : 0) + ((v2 > bb || (v2 == bb && (wi ^ 1) < wi)) ? 1 : 0) + ((v3 > bb || (v3 == bb && (wi ^ 3) < wi)) ? 1 : 0);
          const bool sel = best && rank < 2;
          const float ssel = sel ? sg : 0.f;
          const float gsum = (ssel + BPERM(la4, ssel)) + (BPERM(la8, ssel) + BPERM(la12, ssel));
#undef BPERM
          if (sel && lane < 16) { C.tok_e()[2 * row + rank] = myexp; C.tok_g()[2 * row + rank] = sg / gsum; atomicAdd((int*)(hist + myexp), 1); } }
    }
    __syncthreads();
    if (C.tid < 16) { const int n = hist[C.tid]; if (n) atomicAdd(C.ctl() + CW_CNT + l * 16 + C.tid, (unsigned)n); }
}
#undef DPPX
#undef SWZX
__device__ __forceinline__ void moe_tile_bases(const Ctx& C, int l) {
    LAS int* tb = (LAS int*)(C.lds + LDSCTL_OFF);
    __syncthreads();
    if (C.tid < 16) {
        const int n = (int)__hip_atomic_load(C.ctl() + CW_CNT + l * 16 + C.tid, __ATOMIC_RELAXED, __HIP_MEMORY_SCOPE_AGENT); const int t = (n + 255) >> 8; int x = t;
        x += __builtin_amdgcn_update_dpp(0, x, 0x111, 0xf, 0xf, true); x += __builtin_amdgcn_update_dpp(0, x, 0x112, 0xf, 0xf, true);
        x += __builtin_amdgcn_update_dpp(0, x, 0x114, 0xf, 0xf, true); x += __builtin_amdgcn_update_dpp(0, x, 0x118, 0xf, 0xf, true);
        tb[C.tid] = x - t; if (C.tid == 15) tb[16] = x; }
    __syncthreads();
}
__device__ __forceinline__ void phase_slot(const Ctx& C, int l) {
    const int ntok = (l == 0) ? T : TL;
    moe_tile_bases(C, l);
    const LAS int* tb = (const LAS int*)(C.lds + LDSCTL_OFF);
    LAS int* lcnt = (LAS int*)(C.lds + LDSCTL_OFF) + 32; LAS int* lbase = (LAS int*)(C.lds + LDSCTL_OFF) + 96;
    const int per = (ntok + C.G - 1) / C.G;
    for (int t0 = C.vcu * per; t0 < ntok; t0 += C.G * per) {
        if (C.tid < 16) lcnt[C.tid] = 0;
        __syncthreads();
        const int a = C.tid, t = t0 + (a >> 1); const bool ok = (a < 2 * per) && (t < ntok);
        int e = 0, rank = 0;
        if (ok) { e = C.tok_e()[2 * t + (a & 1)]; rank = atomicAdd((int*)(lcnt + e), 1); }
        __syncthreads();
        if (C.tid < 16) { const int n = lcnt[C.tid]; lbase[C.tid] = n ? (int)atomicAdd(C.ctl() + CW_CUR + l * 16 + C.tid, (unsigned)n) : 0; }
        __syncthreads();
        if (ok) { const int slot = tb[e] * 256 + lbase[e] + rank; C.tok_slot()[2 * t + (a & 1)] = slot; C.rowmap()[slot] = t; C.gslot()[slot] = C.tok_g()[2 * t + (a & 1)]; }
        __syncthreads();
    }
    if (C.vcu < 16) { const int e = C.vcu; const int n = (int)__hip_atomic_load(C.ctl() + CW_CNT + l * 16 + e, __ATOMIC_RELAXED, __HIP_MEMORY_SCOPE_AGENT); const int lo = tb[e] * 256 + n, hi = tb[e + 1] * 256;
        for (int i = lo + C.tid; i < hi; i += 512) { C.rowmap()[i] = 0; C.gslot()[i] = 0.f; } }
}

__device__ __forceinline__ void phase_prep(const Ctx& C, int l) {
    const int gw = C.vcu * NWAVES + C.wave, NGW = C.G * NWAVES;
    const float* cw = C.in[12] + (size_t)l * 3 * RC;
    { const int lane = C.lane;
      typedef unsigned u32x2 __attribute__((ext_vector_type(2)));
      f32x4 tap[3][8]; f32x4 kkw[2];
#pragma unroll
      for (int k3 = 0; k3 < 3; ++k3)
#pragma unroll
          for (int jb = 0; jb < 8; ++jb) tap[k3][jb] = *(const f32x4*)(cw + k3 * RC + 256 * jb + 4 * (jb == 7 ? (lane & 31) : lane));
#pragma unroll
      for (int jj = 0; jj < 2; ++jj) kkw[jj] = *(const f32x4*)(C.in[18] + l * RW + 256 * jj + 4 * lane);
      const int reg = lane < 16 ? 0 : lane < 32 ? 1 : lane < 40 ? 2 : lane < 48 ? 3 : lane < 56 ? 4 : 5;
      const float* qg = C.in[9] + l * 64; const float* kg = C.in[10] + l * 64;
      for (int row = gw; row < T; row += NGW) {
        const bool isc = row >= TL; const int len = isc ? 256 : 4096; const int pos = isc ? ((row - TL) & 255) : (row & 4095);
        const bool hp = pos > 0, hn = pos < len - 1;
        const bf16* u0 = C.ur() + (size_t)row * URP + 4 * lane; bf16* sp_ = C.sc() + (size_t)row * SCP + 4 * lane;
        u32x2 c1[8], c0[8], c2[8];
#pragma unroll
        for (int jb = 0; jb < 8; ++jb) c1[jb] = *(const u32x2*)(u0 + 256 * jb);
        if (hp) {
#pragma unroll
            for (int jb = 0; jb < 8; ++jb) c0[jb] = *(const u32x2*)(u0 - (long)URP + 256 * jb); }
        else {
#pragma unroll
            for (int jb = 0; jb < 8; ++jb) c0[jb] = (u32x2){0u, 0u}; }
        if (hn) {
#pragma unroll
            for (int jb = 0; jb < 8; ++jb) c2[jb] = *(const u32x2*)(u0 + (long)URP + 256 * jb); }
        else {
#pragma unroll
            for (int jb = 0; jb < 8; ++jb) c2[jb] = (u32x2){0u, 0u}; }
        float y[8][4];
#pragma unroll
        for (int jb = 0; jb < 8; ++jb) {
            y[jb][0] = tap[0][jb].x * bflo(c0[jb].x) + tap[1][jb].x * bflo(c1[jb].x) + tap[2][jb].x * bflo(c2[jb].x);
            y[jb][1] = tap[0][jb].y * bfhi(c0[jb].x) + tap[1][jb].y * bfhi(c1[jb].x) + tap[2][jb].y * bfhi(c2[jb].x);
            y[jb][2] = tap[0][jb].z * bflo(c0[jb].y) + tap[1][jb].z * bflo(c1[jb].y) + tap[2][jb].z * bflo(c2[jb].y);
            y[jb][3] = tap[0][jb].w * bfhi(c0[jb].y) + tap[1][jb].w * bfhi(c1[jb].y) + tap[2][jb].w * bfhi(c2[jb].y); }
#pragma unroll
        for (int jb = 0; jb < 6; ++jb) { u32x2 o; o.x = pk2(y[jb][0], y[jb][1]); o.y = pk2(y[jb][2], y[jb][3]); *(u32x2*)(sp_ + 256 * jb) = o; }
#pragma unroll
        for (int jj = 0; jj < 2; ++jj) {
            const float k0 = y[2 + jj][0] * kkw[jj].x, k1 = y[2 + jj][1] * kkw[jj].y, k2 = y[2 + jj][2] * kkw[jj].z, k3v = y[2 + jj][3] * kkw[jj].w;
            const float inv = 1.f / fmaxf(sqrtf(row_sum(k0 * k0 + k1 * k1 + k2 * k2 + k3v * k3v)), 1e-12f);
            u32x2 o; o.x = pk2(k0 * inv, k1 * inv); o.y = pk2(k2 * inv, k3v * inv); *(u32x2*)(sp_ + 3 * RW + 256 * jj) = o; }
        { u32x2 o; float z[4];
#pragma unroll
          for (int e = 0; e < 4; ++e) { const float th = 1.f - 2.f * __builtin_amdgcn_rcpf(__expf(2.f * y[6][e]) + 1.f); z[e] = lane < 32 ? th : y[6][e]; }
          o.x = pk2(z[0], z[1]); o.y = pk2(z[2], z[3]); *(u32x2*)(sp_ + 2560) = o;
          if (lane < 32) {
#pragma unroll
              for (int e = 0; e < 4; ++e) z[e] = 1.f / (1.f + __expf(-y[7][e]));
              o.x = pk2(z[0], z[1]); o.y = pk2(z[2], z[3]); *(u32x2*)(C.sgd() + (size_t)row * 128 + 4 * lane) = o; } }
        if (reg != 3 && reg != 5) {
        bf16* p = C.qkv() + (size_t)row * D + 16 * lane;
        const v4u w0 = *(const v4u*)p, w1 = *(const v4u*)(p + 8);
        float x[16];
        x[0] = bflo(w0.x); x[1] = bfhi(w0.x); x[2] = bflo(w0.y); x[3] = bfhi(w0.y); x[4] = bflo(w0.z); x[5] = bfhi(w0.z); x[6] = bflo(w0.w); x[7] = bfhi(w0.w);
        x[8] = bflo(w1.x); x[9] = bfhi(w1.x); x[10] = bflo(w1.y); x[11] = bfhi(w1.y); x[12] = bflo(w1.z); x[13] = bfhi(w1.z); x[14] = bflo(w1.w); x[15] = bfhi(w1.w);
        const int hc0 = (16 * lane) & 63;
        if (reg == 0 || reg == 2) { float ss = 0.f;
#pragma unroll
            for (int i = 0; i < 16; ++i) ss += x[i] * x[i];
            ss = quad_sum(ss);
            const float rstd = 1.f / sqrtf(ss * (1.f / 64.f) + 1e-6f); const float* gg = (reg == 0 ? qg : kg) + hc0;
#pragma unroll
            for (int i = 0; i < 16; ++i) x[i] = x[i] * rstd * gg[i]; }
        if (row < TL) { const int pos = row & 4095; const float* cp = C.ropec() + pos * 32 + (hc0 >> 1); const float* sp = C.ropes() + pos * 32 + (hc0 >> 1);
#pragma unroll
            for (int i = 0; i < 8; ++i) { const float c = cp[i], s = sp[i], a = x[2 * i], b = x[2 * i + 1]; x[2 * i] = a * c - b * s; x[2 * i + 1] = a * s + b * c; } }
        if (reg < 2) {
#pragma unroll
            for (int i = 0; i < 16; ++i) x[i] *= C2; }
        v4u o0, o1; o0.x = pk2(x[0], x[1]); o0.y = pk2(x[2], x[3]); o0.z = pk2(x[4], x[5]); o0.w = pk2(x[6], x[7]); o1.x = pk2(x[8], x[9]); o1.y = pk2(x[10], x[11]); o1.z = pk2(x[12], x[13]); o1.w = pk2(x[14], x[15]);
        *(v4u*)p = o0; *(v4u*)(p + 8) = o1;
        }
      } }
}

__device__ __forceinline__ int scan_row(int bb, int dir, int n) {
    if (dir == 0) return n < 256 ? TL + bb * 256 + n : bb * 4096 + (n - 256);
    return n < 256 ? TL + bb * 256 + (255 - n) : bb * 4096 + (4095 - (n - 256));
}
__device__ __forceinline__ void phase_attn(const Ctx& C, int l, int pass, bool isA) {
    typedef attn_body::bf16 abf;
    if (isA ? (C.vcu >= 64) : (C.vcu < 64)) return;
    __syncthreads();
    char* shm = (char*)C.lds;
    const abf* Q = (const abf*)C.qkv();
    const int a = C.vcu - 64;
#pragma unroll 1
    for (int i = 0; i < 2; ++i) {
        int u;
        if (i == 0) u = isA ? 2 * (192 + C.vcu) + pass : 2 * a + pass;
        else { if (isA || l != 0 || a >= 32) continue; u = 512 + 2 * a + pass; }
        if (u < 512) { const int b = u >> 6, h = (u >> 4) & 3, qb = u & 15;
            attn_body::attn_unit<8, 0>(Q + ((size_t)b * 4096 + qb * 256) * D + h * 64, Q + 512 + (h >> 1) * 64, Q + 640 + (h >> 1) * 64, TL + b * 256, b * 4096, 68, 0, -INFINITY, shm, C.tid); }
        else { const int x = u - 512, win = x >> 5, b = (x >> 2) & 7, h = x & 3;
            attn_body::attn_unit<8, 0>(Q + ((size_t)TL + b * 256) * D + win * 256 + h * 64, Q + (win ? 768 : 512) + (h >> 1) * 64, Q + (win ? 896 : 640) + (h >> 1) * 64, TL + b * 256, 0, 4, 0,
                                       win ? C.in[11][l * 4 + h] * LOG2E : -INFINITY, shm, C.tid); }
    }
    if (!isA && a >= 64) {
#pragma unroll 1
        for (int i = 0; i < 2; ++i) { const int u = 2 * (2 * (a - 64) + i) + pass; const int b = u >> 6, h = (u >> 4) & 3, qb = u & 15;
            const int lo = (4 * qb - 2 < 0) ? 0 : 4 * qb - 2, hi = (4 * qb + 5 > 63) ? 63 : 4 * qb + 5;
            attn_body::attn_unit<8, 1>(Q + ((size_t)b * 4096 + qb * 256) * D + 256 + h * 64, Q + 768 + (h >> 1) * 64, Q + 896 + (h >> 1) * 64, TL + b * 256, b * 4096 + 64 * lo, 4 + (hi - lo + 1), 64 * lo - 256 * qb,
                                       C.in[11][l * 4 + h] * LOG2E, shm, C.tid); }
    }
}
__device__ __forceinline__ void phase_scanA(const Ctx& C, int l, int d) {
    const int gw = C.vcu * NWAVES + C.wave, NGW = C.G * NWAVES;
    LAS unsigned char* tile = C.lds + C.wave * 5120; LAS float* gam = (LAS float*)(tile + rs::TILE_BYTES);
    const int tbase = C.vcu < 64 ? C.vcu * 16 : 1024 + (C.vcu - 64) * 40, tend = tbase + (C.vcu < 64 ? 16 : 40);
    const int ch0 = tbase / rs::NCHUNK;
    __syncthreads();
    { v4u tl[4];
#pragma unroll
      for (int i = 0; i < 4; ++i) { const int p = C.tid + 512 * i; const int s2 = p >> 10, which = (p >> 9) & 1, rw = (p >> 3) & 63, pc = p & 7; const int hh = (ch0 + s2) & 7;
          tl[i] = *(const v4u*)((which ? C.a2t(l, d) : C.w2t(l, d)) + (size_t)(64 * hh + rw) * 64 + pc * 8); }
      asm volatile("" : "+v"(tl[0]), "+v"(tl[1]), "+v"(tl[2]), "+v"(tl[3]));
#pragma unroll
      for (int i = 0; i < 4; ++i) { const int p = C.tid + 512 * i; const int s2 = p >> 10, which = (p >> 9) & 1, rw = (p >> 3) & 63, pc = p & 7;
          *(LAS v4u*)(C.lds + 40960 + s2 * 18432 + which * 9216 + (rw * 72 + pc * 8) * 2) = tl[i]; } }
    __syncthreads();
#pragma unroll 1
    for (int task = tbase + C.wave; task < tend; task += NWAVES) {
        const int ch = task / rs::NCHUNK, ci = task - ch * rs::NCHUNK, b = ch >> 3, h = ch & 7;
        const int row0 = scan_row(b, d, 32 * ci);
        const rs::ChunkIn in{C.sc() + (size_t)row0 * SCP + h * 64, d ? -(long)SCP : (long)SCP, C.sc() + (size_t)row0 * SCP + 2560};
        const LAS unsigned char* limg = C.lds + 40960 + (ch - ch0) * 18432;
        const rs::LoraIn lo{limg, limg + 9216, C.in[13] + (l * 2 + d) * RW + 64 * h, C.in[15] + (l * 2 + d) * RW + 64 * h, C.sc() + (size_t)row0 * SCP + 3072 + d * RW + h * 64};
        const int lane = fresh_lane();
        float zf; asm volatile("v_mov_b32 %0, 0" : "=v"(zf));
        const float ka = C.in[19][l * RW + h * 64 + lane];
        rs::passA_chunk(in, lo, d, ka, tile, gam, C.wsp() + WS_SCD + (size_t)task * 16384, C.wsp() + WS_STF + (size_t)task * 8192, lane, zf);
    }
}
__device__ __forceinline__ void phase_scanB(const Ctx& C, int d) {
    if (C.vcu >= 64) return;
    constexpr int NS = 5, AHEAD = 4, SLOT = 24576, XB = NS * SLOT;
    const int lane = C.lane, w = C.wave, chain = C.vcu, tj = (w >> 1) & 1, tv = w & 1; const bool comp = w < 4, outw = (w == 4 || w == 5), dmaw = !outw; const int sw = w < 4 ? w : w - 2;
    const int hi = lane >> 5, l31 = lane & 31, b = chain >> 3, h = chain & 7;
    float zf; asm volatile("v_mov_b32 %0, 0" : "=v"(zf));
    rs::f32x16 aS = rs::zero16(zf);
    const unsigned char* dump = C.wsp() + WS_SCD + (size_t)(chain * rs::NCHUNK) * 16384;
    const unsigned char* dump2 = C.wsp() + WS_STF + (size_t)(chain * rs::NCHUNK) * 8192;
    const unsigned ldsb = (unsigned)(uintptr_t)C.lds;
#define SB_DMA(c) do { if (dmaw) { const int c_ = (c) < rs::NCHUNK ? (c) : rs::NCHUNK - 1; const unsigned sl_ = (unsigned)((c) % NS) * (unsigned)SLOT; \
        _Pragma("unroll") for (int i_ = 0; i_ < 4; ++i_) { const int p_ = 4 * sw + i_; \
            const unsigned char* src_ = p_ < 16 ? dump + (size_t)c_ * 16384 + p_ * 1024 : dump2 + (size_t)c_ * 8192 + (p_ - 16) * 1024; \
            pg8::glds16s(src_, (unsigned)(lane * 16), (unsigned)__builtin_amdgcn_readfirstlane((int)(ldsb + sl_ + p_ * 1024))); } } } while (0)
#pragma unroll 1
    for (int c = 0; c < AHEAD; ++c) SB_DMA(c);
    asm volatile("s_waitcnt vmcnt(0)" ::: "memory");
#pragma unroll 1
    for (int ci = 0; ci < rs::NCHUNK; ++ci) {
        LAS unsigned char* xw = C.lds + XB + (ci & 1) * 8192; LAS unsigned char* rg = C.lds + (ci % NS) * SLOT;
        if (comp) { const rs::bf16x8 p0 = rs::packq(aS, 0), p1 = rs::packq(aS, 1);
            *(LAS rs::bf16x8*)(xw + w * 2048 + lane * 16) = p0; *(LAS rs::bf16x8*)(xw + w * 2048 + 1024 + lane * 16) = p1; }
        if (dmaw) asm volatile("s_waitcnt vmcnt(12) lgkmcnt(0)\n\ts_barrier" ::: "memory");
        else asm volatile("s_waitcnt lgkmcnt(0)\n\ts_barrier" ::: "memory");
        if (comp) {
            rs::bf16x8 g0 = *(const LAS rs::bf16x8*)(rg + (8 + w * 2) * 1024 + lane * 16), g1 = *(const LAS rs::bf16x8*)(rg + (8 + w * 2 + 1) * 1024 + lane * 16), fm[4], fx[4];
#pragma unroll
            for (int i = 0; i < 4; ++i) { fm[i] = *(const LAS rs::bf16x8*)(rg + (((i >> 1) * 2 + tj) * 2 + (i & 1)) * 1024 + lane * 16); fx[i] = *(const LAS rs::bf16x8*)(xw + ((i >> 1) * 2 + tv) * 2048 + (i & 1) * 1024 + lane * 16); }
            asm volatile("" : "+v"(g0), "+v"(g1), "+v"(fm[0]), "+v"(fm[1]), "+v"(fm[2]), "+v"(fm[3]), "+v"(fx[0]), "+v"(fx[1]), "+v"(fx[2]), "+v"(fx[3]));
            rs::f32x16 a = rs::unpack16(g0, g1);
#pragma unroll
            for (int i = 0; i < 4; ++i) a = rs::mf(fm[i], fx[i], a);
            aS = a; }
        if (outw) { const int ov = w - 4;
            rs::bf16x8 g0 = *(const LAS rs::bf16x8*)(rg + (16 + 4 + ov * 2) * 1024 + lane * 16), g1 = *(const LAS rs::bf16x8*)(rg + (16 + 4 + ov * 2 + 1) * 1024 + lane * 16), fm[4], fx[4];
#pragma unroll
            for (int i = 0; i < 4; ++i) { fm[i] = *(const LAS rs::bf16x8*)(rg + (16 + (i >> 1) * 2 + (i & 1)) * 1024 + lane * 16); fx[i] = *(const LAS rs::bf16x8*)(xw + ((i >> 1) * 2 + ov) * 2048 + (i & 1) * 1024 + lane * 16); }
            asm volatile("" : "+v"(g0), "+v"(g1), "+v"(fm[0]), "+v"(fm[1]), "+v"(fm[2]), "+v"(fm[3]), "+v"(fx[0]), "+v"(fx[1]), "+v"(fx[2]), "+v"(fx[3]));
            rs::f32x16 a = rs::unpack16(g0, g1);
#pragma unroll
            for (int i = 0; i < 4; ++i) a = rs::mf(fm[i], fx[i], a);
            const int row0 = scan_row(b, d, 32 * ci); const long rs_ = d ? -(long)SCP : (long)SCP;
            bf16* o0 = C.sc() + (size_t)row0 * SCP + 2048 + d * RW + h * 64 + 32 * ov + l31;
#pragma unroll
            for (int r = 0; r < 16; r += 2) { const unsigned p = rs::pk(a[r], a[r + 1]);
                o0[(long)rs::crow(r, hi) * rs_] = (bf16)(p & 0xffffu); o0[(long)rs::crow(r + 1, hi) * rs_] = (bf16)(p >> 16); } }
        asm volatile("s_waitcnt lgkmcnt(0)" ::: "memory");
        SB_DMA(ci + AHEAD);
    }
    asm volatile("s_waitcnt vmcnt(0)" ::: "memory");
#undef SB_DMA
}
__device__ __forceinline__ void phase_rwkvout(const Ctx& C, int l) {
    typedef rs::bf16x8 bx8; typedef rs::f32x16 fx16;
    const int ntile = ((l == 0) ? T : TL) / 32;
    const int chh = (C.vcu & 1) * 256;
    __syncthreads();
    { const bf16* g2s = C.g2t(l) + (size_t)chh * 128;
      v4u tg[8]; float tp[3];
#pragma unroll
      for (int i = 0; i < 8; ++i) { const int p = C.tid + 512 * i, rw = p >> 4, pc = p & 15; tg[i] = *(const v4u*)(g2s + (size_t)rw * 128 + pc * 8); }
#pragma unroll
      for (int i = 0; i < 3; ++i) { const int p = C.tid + 512 * i; const int pp = p < 5 * 256 ? p : 0; const int which = pp >> 8, c = chh + (pp & 255);
          const float* src = which == 0 ? C.in[21] + l * RW : which == 1 ? C.in[22] + l * RW : which == 2 ? C.in[19] + l * RW : C.in[20] + (l * 2 + (which - 3)) * RW;
          tp[i] = src[c]; }
      asm volatile("" : "+v"(tg[0]), "+v"(tg[1]), "+v"(tg[2]), "+v"(tg[3]), "+v"(tg[4]), "+v"(tg[5]), "+v"(tg[6]), "+v"(tg[7]), "+v"(tp[0]), "+v"(tp[1]), "+v"(tp[2]));
#pragma unroll
      for (int i = 0; i < 8; ++i) { const int p = C.tid + 512 * i, rw = p >> 4, pc = p & 15; *(LAS v4u*)(C.lds + (rw * 136 + pc * 8) * 2) = tg[i]; }
#pragma unroll
      for (int i = 0; i < 3; ++i) { const int p = C.tid + 512 * i; if (p < 5 * 256) *(LAS float*)(C.lds + 69632 + p * 4) = tp[i]; } }
    __syncthreads();
    const int wv = (C.vcu >> 1) * NWAVES + C.wave, NWV = (C.G >> 1) * NWAVES;
    float zf; asm volatile("v_mov_b32 %0, 0" : "=v"(zf));
    const LAS float* prm = (const LAS float*)(C.lds + 69632);
    for (int task = wv; task < ntile * 4; task += NWV) {
        int ln = C.lane; asm volatile("" : "+v"(ln));
        const int tt = task >> 2, hl = task & 3;
        const int t = ln & 31, hi = ln >> 5; const int row = tt * 32 + t;
        const bf16* sp = C.sc() + (size_t)row * SCP;
        const int arow = 16 * ((t >> 3) >> 1) + 8 * ((t >> 2) & 1) + 4 * ((t >> 3) & 1) + (t & 3);
        const int hd = (chh >> 6) + hl; const int cb = 64 * hd + 8 * hi, cl = 64 * hl + 8 * hi;
        v4u f[4], b[4], vv[4], rr[4], kk[4], a0[4], a1[4]; bx8 sg[8];
#pragma unroll
        for (int i = 0; i < 4; ++i) { const int c0 = cb + 16 * i; f[i] = *(const v4u*)(sp + 2048 + c0); b[i] = *(const v4u*)(sp + 2048 + RW + c0); vv[i] = *(const v4u*)(sp + 2 * RW + c0); }
#pragma unroll
        for (int q = 0; q < 8; ++q) sg[q] = __builtin_bit_cast(bx8, *(const v4u*)(C.sgd() + (size_t)row * 128 + 16 * q + 8 * hi));
#pragma unroll
        for (int i = 0; i < 4; ++i) { const int c0 = cb + 16 * i; rr[i] = *(const v4u*)(sp + c0); kk[i] = *(const v4u*)(sp + RW + c0); a0[i] = *(const v4u*)(sp + 3072 + c0); a1[i] = *(const v4u*)(sp + 3072 + RW + c0); }
        asm volatile("" : "+v"(f[0]), "+v"(f[1]), "+v"(f[2]), "+v"(f[3]), "+v"(b[0]), "+v"(b[1]), "+v"(b[2]), "+v"(b[3]), "+v"(vv[0]), "+v"(vv[1]), "+v"(vv[2]), "+v"(vv[3]),
                     "+v"(sg[0]), "+v"(sg[1]), "+v"(sg[2]), "+v"(sg[3]), "+v"(sg[4]), "+v"(sg[5]), "+v"(sg[6]), "+v"(sg[7]));
        float on[4][8]; float s1 = zf;
#pragma unroll
        for (int i = 0; i < 4; ++i) { const v4u ff = f[i], bb = b[i];
            on[i][0] = bflo(ff.x) + bflo(bb.x); on[i][1] = bfhi(ff.x) + bfhi(bb.x); on[i][2] = bflo(ff.y) + bflo(bb.y); on[i][3] = bfhi(ff.y) + bfhi(bb.y);
            on[i][4] = bflo(ff.z) + bflo(bb.z); on[i][5] = bfhi(ff.z) + bfhi(bb.z); on[i][6] = bflo(ff.w) + bflo(bb.w); on[i][7] = bfhi(ff.w) + bfhi(bb.w);
#pragma unroll
            for (int e = 0; e < 8; ++e) s1 += on[i][e]; }
        const float mu = half_sum2(s1) * (1.f / 64.f); float s2 = zf;
#pragma unroll
        for (int i = 0; i < 4; ++i)
#pragma unroll
            for (int e = 0; e < 8; ++e) { const float dv = on[i][e] - mu; on[i][e] = dv; s2 += dv * dv; }
        const float rstd = 1.f / sqrtf(half_sum2(s2) * (1.f / 64.f) + 64e-5f);
        asm volatile("" : "+v"(rr[0]), "+v"(rr[1]), "+v"(rr[2]), "+v"(rr[3]), "+v"(kk[0]), "+v"(kk[1]), "+v"(kk[2]), "+v"(kk[3]), "+v"(a0[0]), "+v"(a0[1]), "+v"(a0[2]), "+v"(a0[3]), "+v"(a1[0]), "+v"(a1[1]), "+v"(a1[2]), "+v"(a1[3]));
        float bsum = zf;
#pragma unroll
        for (int i = 0; i < 4; ++i) {
            f32x4 pw[10];
#pragma unroll
            for (int hf = 0; hf < 2; ++hf)
#pragma unroll
                for (int p = 0; p < 5; ++p) pw[hf * 5 + p] = *(const LAS f32x4*)(prm + p * 256 + cl + 16 * i + 4 * hf);
            asm volatile("" : "+v"(pw[0]), "+v"(pw[1]), "+v"(pw[2]), "+v"(pw[3]), "+v"(pw[4]), "+v"(pw[5]), "+v"(pw[6]), "+v"(pw[7]), "+v"(pw[8]), "+v"(pw[9]));
            const v4u rr_ = rr[i], kk_ = kk[i], a0_ = a0[i], a1_ = a1[i];
            const float rv[8] = {bflo(rr_.x), bfhi(rr_.x), bflo(rr_.y), bfhi(rr_.y), bflo(rr_.z), bfhi(rr_.z), bflo(rr_.w), bfhi(rr_.w)}, kv[8] = {bflo(kk_.x), bfhi(kk_.x), bflo(kk_.y), bfhi(kk_.y), bflo(kk_.z), bfhi(kk_.z), bflo(kk_.w), bfhi(kk_.w)};
            const float a0v[8] = {bflo(a0_.x), bfhi(a0_.x), bflo(a0_.y), bfhi(a0_.y), bflo(a0_.z), bfhi(a0_.z), bflo(a0_.w), bfhi(a0_.w)}, a1v[8] = {bflo(a1_.x), bfhi(a1_.x), bflo(a1_.y), bfhi(a1_.y), bflo(a1_.z), bfhi(a1_.z), bflo(a1_.w), bfhi(a1_.w)};
#pragma unroll
            for (int hf = 0; hf < 2; ++hf) { const f32x4 lw = pw[hf * 5], lb = pw[hf * 5 + 1], ka = pw[hf * 5 + 2], rk0 = pw[hf * 5 + 3], rk1 = pw[hf * 5 + 4];
#pragma unroll
                for (int e = 0; e < 4; ++e) { const int e8 = 4 * hf + e; on[i][e8] = on[i][e8] * rstd * lw[e] + lb[e];
                    bsum += rv[e8] * kv[e8] * ((1.f + (a0v[e8] - 1.f) * ka[e]) * rk0[e] + (1.f + (a1v[e8] - 1.f) * ka[e]) * rk1[e]); } } }
        const float bonus = half_sum2(bsum);
#pragma unroll
        for (int ctl = 0; ctl < 2; ++ctl) {
            bx8 gq[8];
#pragma unroll
            for (int q = 0; q < 8; ++q) gq[q] = *(const LAS bx8*)(C.lds + ((64 * hl + 32 * ctl + arow) * 136 + 16 * q + 8 * hi) * 2);
            asm volatile("" : "+v"(gq[0]), "+v"(gq[1]), "+v"(gq[2]), "+v"(gq[3]), "+v"(gq[4]), "+v"(gq[5]), "+v"(gq[6]), "+v"(gq[7]));
            fx16 ag = rs::zero16(zf);
#pragma unroll
            for (int q = 0; q < 8; ++q) ag = rs::mf(gq[q], sg[q], ag);
#pragma unroll
            for (int a2 = 0; a2 < 2; ++a2) { const int i = 2 * ctl + a2; const v4u v_ = vv[i];
                const float v8[8] = {bflo(v_.x), bfhi(v_.x), bflo(v_.y), bfhi(v_.y), bflo(v_.z), bfhi(v_.z), bflo(v_.w), bfhi(v_.w)}; float o8[8];
#pragma unroll
                for (int e = 0; e < 8; ++e) o8[e] = (on[i][e] + bonus * v8[e]) * ag[8 * a2 + e];
                v4u po; po.x = rs::pk(o8[0], o8[1]); po.y = rs::pk(o8[2], o8[3]); po.z = rs::pk(o8[4], o8[5]); po.w = rs::pk(o8[6], o8[7]);
                *(v4u*)(C.qkv() + (size_t)row * D + 512 + cb + 16 * i) = po; }
        }
    }
}

constexpr int NPL = 13;
constexpr int NPH = 1 + DEPTH * NPL + 1;

__global__ void __launch_bounds__(NWAVES * 64, 2) mega_fwd(Args args) {
    extern __shared__ __attribute__((aligned(16))) unsigned char lds[];
    Ctx C;
    C.out = (__attribute__((address_space(1))) float*)args.out; C.ws = (__attribute__((address_space(1))) unsigned char*)args.ws;
    C.lds = (LAS unsigned char*)lds; C.tid = threadIdx.x; C.lane = C.tid & 63; C.wave = __builtin_amdgcn_readfirstlane(C.tid >> 6);
    C.G = gridDim.x; { const int bx = blockIdx.x; C.vcu = (C.G % 8 == 0) ? (bx % 8) * (C.G / 8) + bx / 8 : bx; }
    for (int u = C.tid; u < (LDS_BYTES - LDSCTL_OFF) / 4; u += NWAVES * 64) ((LAS unsigned*)(C.lds + LDSCTL_OFF))[u] = 0u;
    __syncthreads();
    XcdBarrier bar; bar.bar = C.ctl() + CW_BAR; bar.x = 0; bar.st = nullptr;
    if (args.use_bar) bar = xcd_barrier_post(C.ctl() + CW_BAR, (volatile LAS unsigned*)(C.lds + LDSCTL_OFF) + 56, C.tid);
    const int lo = args.ph_lo, hi = args.ph_hi;
    unsigned ldsv = (unsigned)(uintptr_t)C.lds;
    int wave_s = C.wave;
#define FRESH() { int z_; asm volatile("s_mov_b32 %0, 0" : "=s"(z_)); asm volatile("" : "+s"(C.ws), "+s"(C.out), "+s"(wave_s), "+s"(C.vcu), "+s"(C.G), "+s"(ldsv)); C.lds = (LAS unsigned char*)(uintptr_t)ldsv; \
    C.lane = (int)__builtin_amdgcn_mbcnt_hi(~0u, __builtin_amdgcn_mbcnt_lo(~0u, (unsigned)z_)); C.wave = wave_s; C.tid = (wave_s << 6) | C.lane; }
#define IN(k) (lo <= (k) && (k) < hi)
#define SEAM(k) do { if ((lo <= (k) && (k) < hi) && (lo <= (k) + 1 && (k) + 1 < hi)) { if (args.use_bar) xcd_barrier(bar, C.tid); } } while (0)

    int ph = 0;
#define PH_BEGIN FRESH() if (IN(ph)) {
#define PH_END } SEAM(ph); ++ph;
    PH_BEGIN phase_prologue(C); PH_END
#pragma unroll 1
    for (int l = 0; l < DEPTH; ++l) {
        PH_BEGIN phase_norm1(C, l); PH_END
        PH_BEGIN
            pg8::Gemm g{C.xn(), C.w_in_t(l), T, INP, D, nullptr}; pg8::StaticOrder S; S.init(T, INP, C.G, (int)blockIdx.x);
            EpiIn E{C.qkv(), C.ur()};
            pg8::gemm_phase<EpiIn, pg8::StaticOrder, true, false>(C.lds, g, S, E, C.tid);
        PH_END
        PH_BEGIN phase_prep(C, l); PH_END
#pragma unroll 1
        for (int sp = 0; sp < 4; ++sp) {
            const int d = sp >> 1; const bool isA = !(sp & 1);
            PH_BEGIN
                if (isA) phase_scanA(C, l, d); else if (C.vcu < 64) phase_scanB(C, d);
                FRESH()
                phase_attn(C, l, d, isA);
            PH_END
        }
        PH_BEGIN phase_rwkvout(C, l); PH_END
        PH_BEGIN
            const int Mo = (l == 0) ? T : TL;
            pg8::Gemm g{C.qkv(), C.w_out_t(l), Mo, D, D, nullptr}; pg8::StaticOrder S; S.init(Mo, D, C.G, (int)blockIdx.x);
            EpiOut E{C.hb(0), C.hb(TL), C.mods(l) + 2 * 1024};
            pg8::gemm_phase<EpiOut, pg8::StaticOrder, true, false>(C.lds, g, S, E, C.tid);
            phase_wconv(C, l);
        PH_END
        PH_BEGIN phase_norm2(C, l); PH_END
        PH_BEGIN phase_slot(C, l); PH_END
        PH_BEGIN
            moe_tile_bases(C, l);
            const LAS int* tb = (const LAS int*)(C.lds + LDSCTL_OFF); LAS int* rmc = (LAS int*)(C.lds + RMC_OFF);
            pg8::MoeOrder S; S.init(tb[16], 8, C.G, (int)blockIdx.x, tb);
            { int rws[12];
#pragma unroll
              for (int i = 0; i < 12; ++i) { pg8::Unit u; const bool ok = S.next(i, u); rws[i] = (ok && C.tid < 256) ? C.rowmap()[u.pm * 256 + C.tid] : 0; }
              asm volatile("" : "+v"(rws[0]), "+v"(rws[1]), "+v"(rws[2]), "+v"(rws[3]), "+v"(rws[4]), "+v"(rws[5]), "+v"(rws[6]), "+v"(rws[7]), "+v"(rws[8]), "+v"(rws[9]), "+v"(rws[10]), "+v"(rws[11]));
#pragma unroll
              for (int i = 0; i < 12; ++i) if (C.tid < 256) rmc[i * 256 + C.tid] = rws[i]; }
            __syncthreads();
            pg8::Gemm g{C.xn(), C.wgu(), tb[16] * 256, 2048, D, rmc};
            EpiGU E{C.hmid()};
            pg8::gemm_phase<EpiGU, pg8::MoeOrder, true, true>(C.lds, g, S, E, C.tid);
        PH_END
        PH_BEGIN
            moe_tile_bases(C, l);
            const LAS int* tb = (const LAS int*)(C.lds + LDSCTL_OFF);
            pg8::MoeOrder S; S.init(tb[16], 4, C.G, (int)blockIdx.x, tb);
            pg8::Gemm g{C.hmid(), C.wdn(), tb[16] * 256, 1024, D, nullptr};
            EpiDN E{C.ybuf(), C.gslot()};
            pg8::gemm_phase<EpiDN, pg8::MoeOrder, true, false>(C.lds, g, S, E, C.tid);
        PH_END
    }
    PH_BEGIN phase_final(C); PH_END
#undef PH_BEGIN
#undef PH_END
#undef IN
#undef SEAM
}

extern "C" void kernel_launch(void* const* d_in, const int* in_sizes, int n_in, void* d_out, int out_size, void* d_ws, size_t ws_size, hipStream_t stream) {
    static int grid = 0;
    if (grid == 0) {
        if (n_in != 30 || out_size != TL * D || ws_size < WS_END) { fprintf(stderr, "kernel_launch: unexpected shapes: n_in %d out %d ws %zu (need %zu)\n", n_in, out_size, ws_size, (size_t)WS_END); grid = -1; return; }
        int dev = 0, cus = 0, per_cu = 0;
        if (hipGetDevice(&dev) != hipSuccess || hipDeviceGetAttribute(&cus, hipDeviceAttributeMultiprocessorCount, dev) != hipSuccess) { grid = -1; return; }
        if (hipFuncSetAttribute((const void*)mega_fwd, hipFuncAttributeMaxDynamicSharedMemorySize, LDS_BYTES) != hipSuccess) { fprintf(stderr, "kernel_launch: hipFuncSetAttribute failed\n"); grid = -1; return; }
        if (hipOccupancyMaxActiveBlocksPerMultiprocessor(&per_cu, (const void*)mega_fwd, NWAVES * 64, LDS_BYTES) != hipSuccess || per_cu < 1) { fprintf(stderr, "kernel_launch: occupancy query says %d\n", per_cu); }
        (void)hipGetLastError();
        grid = cus;
    }
    if (grid < 0) return;
    if (hipMemsetAsync((char*)d_ws + WS_CTL, 0, CTL_ZERO_BYTES, stream) != hipSuccess) return;
    Args a{};
    for (int i = 0; i < 30; ++i) a.in[i] = (const float*)d_in[i];
    a.out = (float*)d_out; a.ws = (unsigned char*)d_ws;
#if MK_PER_PHASE
    for (int p = 0; p < NPH; ++p) { a.ph_lo = p; a.ph_hi = p + 1; a.use_bar = 0; hipLaunchKernelGGL(mega_fwd, dim3(grid), dim3(NWAVES * 64), LDS_BYTES, stream, a); }
#else
    a.ph_lo = 0; a.ph_hi = NPH; a.use_bar = 1;
    hipLaunchKernelGGL(mega_fwd, dim3(grid), dim3(NWAVES * 64), LDS_BYTES, stream, a);
#endif
}
```
